# Optimizing an MI355X kernel written in HIP

```python
import jax, jax.numpy as jnp
from jax import lax
import numpy as np

D_MODEL = 1024
BATCH = 8
SEQ = 4096
DEPTH = 1
DEC_BATCH = 16
DEC_SEQ = 16
PAST_LEN = 2048

CHUNK = 64
N_MEM = 256
N_XHEADS = 4
XHEAD_DIM = D_MODEL // N_XHEADS
D_CONV = 512
CONV_WIDTH = 31
CONV_BUF = CONV_WIDTH - 1
D_RWKV = 1024
RWKV_HEAD = 64
RWKV_HEADS = D_RWKV // RWKV_HEAD
D_DECAY_LORA = 64
D_AAA_LORA = 64
D_GATE_LORA = 128
N_BRANCH = 2
D_FF = -(-8 * D_MODEL // (3 * 256)) * 256
EPS_RMS = 1e-6
EPS_LN = 1e-5
EPS_GN = RWKV_HEAD * 1e-5
D_SHIFT = 3 * D_RWKV + D_DECAY_LORA + D_AAA_LORA + D_GATE_LORA
OFF_RWKV = 2 * D_CONV
OFF_GATE = OFF_RWKV + D_SHIFT
D_IN = OFF_GATE + N_BRANCH * D_MODEL

kernel_name = "gated_conformer_rwkv7_stream_step"


def _rms(x, g):
    xf = x.astype(jnp.float32)
    y = xf * lax.rsqrt(jnp.mean(xf * xf, -1, keepdims=True) + EPS_RMS) * g.astype(jnp.float32)
    return y.astype(x.dtype)


def _layernorm(x, g, b):
    xf = x.astype(jnp.float32)
    mu = jnp.mean(xf, -1, keepdims=True)
    var = jnp.mean(jnp.square(xf - mu), -1, keepdims=True)
    return ((xf - mu) * lax.rsqrt(var + EPS_LN) * g.astype(jnp.float32) + b.astype(jnp.float32)).astype(x.dtype)


def _wkv7(r, w, k, v, kk, a, s0):
    def step(S, inp):
        r_t, w_t, k_t, v_t, kk_t, a_t = inp
        sa = jnp.einsum('bhvk,bhk->bhv', S, -kk_t)
        S = (S * w_t[:, :, None, :] + sa[..., None] * (kk_t * a_t)[:, :, None, :]
             + v_t[..., None] * k_t[:, :, None, :])
        return S, jnp.einsum('bhvk,bhk->bhv', S, r_t)
    xs = tuple(jnp.moveaxis(t, 1, 0) for t in (r, w, k, v, kk, a))
    s_fin, ys = lax.scan(step, s0, xs)
    return jnp.moveaxis(ys, 0, 1), s_fin


def _mixer(xn, conv_buf, shift_buf, wkv_state, p):
    f32 = jnp.float32
    B, T, _ = xn.shape
    proj = xn @ p["w_in"]
    conv_in = proj[..., :OFF_RWKV]
    pr = proj[..., OFF_RWKV:OFF_GATE]
    gates = jax.nn.sigmoid(proj[..., OFF_GATE:])

    u = conv_in[..., :D_CONV] * jax.nn.sigmoid(conv_in[..., D_CONV:])
    u_pad = jnp.concatenate([conv_buf.astype(u.dtype), u], 1)
    c = lax.conv_general_dilated(u_pad, p["w_dw"][:, None, :], (1,), 'VALID',
                                 dimension_numbers=('NWC', 'WIO', 'NWC'),
                                 feature_group_count=D_CONV) + p["b_dw"]
    c = _layernorm(c, p["ln_conv_g"], p["ln_conv_b"])
    conv_out = jax.nn.silu(c) @ p["w_o_conv"]
    new_conv = u_pad[:, -CONV_BUF:]

    pr_prev = jnp.concatenate([shift_buf.astype(pr.dtype), pr[:, :-1]], 1)
    pm = pr + (pr_prev - pr) * p["mu_shift"]
    new_shift = pr[:, -1:]
    o1 = D_RWKV; o2 = 2 * D_RWKV; o3 = 3 * D_RWKV
    o4 = o3 + D_DECAY_LORA; o5 = o4 + D_AAA_LORA
    r, k, v, wd, ad, gd = jnp.split(pm, [o1, o2, o3, o4, o5], -1)
    w_log = -jax.nn.softplus(-(p["w0"] + jnp.tanh(wd) @ p["w_up"]).astype(f32)) - 0.5
    decay = jnp.exp(-jnp.exp(w_log))
    a = jax.nn.sigmoid((p["a0"] + ad @ p["a_up"]).astype(f32))
    g = jax.nn.sigmoid(gd) @ p["g_up"]
    hs = (B, T, RWKV_HEADS, RWKV_HEAD)
    kf = k.astype(f32)
    kk = (kf * p["k_k"].astype(f32)).reshape(hs)
    kk = kk / jnp.maximum(jnp.sqrt(jnp.sum(kk * kk, -1, keepdims=True)), 1e-12)
    kf = kf * (1.0 + (a - 1.0) * p["k_a"].astype(f32))
    rh = r.astype(f32).reshape(hs)
    kh = kf.reshape(hs)
    vh = v.astype(f32).reshape(hs)
    y, new_wkv = _wkv7(rh, decay.reshape(hs), kh, vh, kk, a.reshape(hs), wkv_state.astype(f32))
    mu = jnp.mean(y, -1, keepdims=True)
    var = jnp.mean(jnp.square(y - mu), -1, keepdims=True)
    y = ((y - mu) * lax.rsqrt(var + EPS_GN)).reshape(B, T, D_RWKV)
    y = y * p["ln_x_g"].astype(f32) + p["ln_x_b"].astype(f32)
    bonus = jnp.sum(rh * kh * p["r_k"].astype(f32), -1, keepdims=True) * vh
    y = y + bonus.reshape(B, T, D_RWKV)
    rwkv_out = (y.astype(xn.dtype) * g) @ p["w_o_rwkv"]

    merged = gates[..., :D_MODEL] * conv_out + gates[..., D_MODEL:] * rwkv_out
    return merged @ p["w_out"], new_conv, new_shift, new_wkv.astype(xn.dtype)


def _mem_kv(mem, g_mem, w_k_mem, w_v_mem):
    B = mem.shape[0]
    mn = _rms(mem, g_mem)
    mk = (mn @ w_k_mem).reshape(B, N_MEM, N_XHEADS, XHEAD_DIM)
    mv = (mn @ w_v_mem).reshape(B, N_MEM, N_XHEADS, XHEAD_DIM)
    return mk, mv


def _cross_attn(xn, mem_k, mem_v, w_q_x, w_o_x):
    B, T, _ = xn.shape
    q = (xn @ w_q_x).reshape(B, T, N_XHEADS, XHEAD_DIM)
    s = jnp.einsum('bthd,bmhd->bhtm', q, mem_k.astype(q.dtype)).astype(jnp.float32) * (XHEAD_DIM ** -0.5)
    pw = jax.nn.softmax(s, -1).astype(xn.dtype)
    o = jnp.einsum('bhtm,bmhd->bthd', pw, mem_v.astype(xn.dtype)).reshape(B, T, D_MODEL)
    return o @ w_o_x


def _swiglu(xn, w_gate, w_up, w_down):
    return (jax.nn.silu(xn @ w_gate) * (xn @ w_up)) @ w_down


def _layer(x, mem_k, mem_v, conv_buf, shift_buf, wkv_state, p):
    mix, new_conv, new_shift, new_wkv = _mixer(_rms(x, p["g_norm_mix"]), conv_buf, shift_buf, wkv_state, p)
    h = x + mix
    h = h + _cross_attn(_rms(h, p["g_norm_x"]), mem_k, mem_v, p["w_q_x"], p["w_o_x"])
    h = h + _swiglu(_rms(h, p["g_norm_ffn"]), p["w_ffn_gate"], p["w_ffn_up"], p["w_ffn_down"])
    return h, new_conv, new_shift, new_wkv


def setup_inputs(seed: int = 0) -> dict:
    key = jax.random.key(seed)
    ks = iter(jax.random.split(key, 64))
    f32 = jnp.float32
    L = DEPTH
    D = D_MODEL

    def nrm(shape, scale):
        return jax.random.normal(next(ks), shape, f32) * scale

    def gain(shape):
        return 1.0 + nrm(shape, 0.02)

    def unif(shape, lo, hi):
        return jax.random.uniform(next(ks), shape, f32, lo, hi)

    return {
        "x_prompt": nrm((BATCH, SEQ, D), 1.0),
        "x_sample": nrm((DEC_BATCH, DEC_SEQ, D), 1.0),
        "cache_mem_k": nrm((L, DEC_BATCH, N_MEM, N_XHEADS, XHEAD_DIM), 1.0),
        "cache_mem_v": nrm((L, DEC_BATCH, N_MEM, N_XHEADS, XHEAD_DIM), 1.0),
        "state_conv": nrm((L, DEC_BATCH, CONV_BUF, D_CONV), 0.5),
        "state_shift": nrm((L, DEC_BATCH, 1, D_SHIFT), 1.0),
        "state_wkv": nrm((L, DEC_BATCH, RWKV_HEADS, RWKV_HEAD, RWKV_HEAD), 1.0),
        "mem_prompt": nrm((BATCH, N_MEM, D), 1.0),
        "g_norm_mix": gain((L, D)),
        "w_in": nrm((L, D, D_IN), D ** -0.5),
        "mu_shift": unif((L, D_SHIFT), 0.0, 1.0),
        "w_dw": nrm((L, CONV_WIDTH, D_CONV), CONV_WIDTH ** -0.5),
        "b_dw": nrm((L, D_CONV), 0.02),
        "ln_conv_g": gain((L, D_CONV)),
        "ln_conv_b": nrm((L, D_CONV), 0.02),
        "w_o_conv": nrm((L, D_CONV, D), D_CONV ** -0.5),
        "w0": unif((L, D_RWKV), -3.0, 1.0),
        "w_up": nrm((L, D_DECAY_LORA, D_RWKV), 0.5 * D_DECAY_LORA ** -0.5),
        "a0": nrm((L, D_RWKV), 0.1),
        "a_up": nrm((L, D_AAA_LORA, D_RWKV), 0.5 * D_AAA_LORA ** -0.5),
        "g_up": nrm((L, D_GATE_LORA, D_RWKV), D_GATE_LORA ** -0.5),
        "k_k": 0.85 + nrm((L, D_RWKV), 0.02),
        "k_a": gain((L, D_RWKV)),
        "r_k": nrm((L, RWKV_HEADS, RWKV_HEAD), 0.1),
        "ln_x_g": gain((L, D_RWKV)),
        "ln_x_b": nrm((L, D_RWKV), 0.02),
        "w_o_rwkv": nrm((L, D_RWKV, D), D_RWKV ** -0.5),
        "w_out": nrm((L, D, D), D ** -0.5),
        "g_norm_x": gain((L, D)),
        "g_mem": gain((L, D)),
        "w_q_x": nrm((L, D, D), D ** -0.5),
        "w_k_mem": nrm((L, D, D), D ** -0.5),
        "w_v_mem": nrm((L, D, D), D ** -0.5),
        "w_o_x": nrm((L, D, D), D ** -0.5),
        "g_norm_ffn": gain((L, D)),
        "w_ffn_gate": nrm((L, D, D_FF), D ** -0.5),
        "w_ffn_up": nrm((L, D, D_FF), D ** -0.5),
        "w_ffn_down": nrm((L, D_FF, D), D_FF ** -0.5),
        "g_norm_final": gain((D,)),
    }


def reference(x_prompt, x_sample, cache_mem_k, cache_mem_v, state_conv, state_shift, state_wkv, mem_prompt,
              g_norm_mix, w_in, mu_shift, w_dw, b_dw, ln_conv_g, ln_conv_b, w_o_conv,
              w0, w_up, a0, a_up, g_up, k_k, k_a, r_k, ln_x_g, ln_x_b, w_o_rwkv, w_out,
              g_norm_x, g_mem, w_q_x, w_k_mem, w_v_mem, w_o_x,
              g_norm_ffn, w_ffn_gate, w_ffn_up, w_ffn_down, g_norm_final):
    Bp = x_prompt.shape[0]
    dt = x_prompt.dtype
    hp, hs = x_prompt, x_sample
    mk_l, mv_l, cp_l, sp_l, wp_l, cs_l, ss_l, ws_l = [], [], [], [], [], [], [], []
    for i in range(DEPTH):
        p = {
            "g_norm_mix": g_norm_mix[i], "w_in": w_in[i], "mu_shift": mu_shift[i],
            "w_dw": w_dw[i], "b_dw": b_dw[i], "ln_conv_g": ln_conv_g[i], "ln_conv_b": ln_conv_b[i],
            "w_o_conv": w_o_conv[i], "w0": w0[i], "w_up": w_up[i], "a0": a0[i], "a_up": a_up[i],
            "g_up": g_up[i], "k_k": k_k[i], "k_a": k_a[i], "r_k": r_k[i], "ln_x_g": ln_x_g[i],
            "ln_x_b": ln_x_b[i], "w_o_rwkv": w_o_rwkv[i], "w_out": w_out[i],
            "g_norm_x": g_norm_x[i], "w_q_x": w_q_x[i], "w_o_x": w_o_x[i],
            "g_norm_ffn": g_norm_ffn[i], "w_ffn_gate": w_ffn_gate[i], "w_ffn_up": w_ffn_up[i],
            "w_ffn_down": w_ffn_down[i],
        }
        mk, mv = _mem_kv(mem_prompt, g_mem[i], w_k_mem[i], w_v_mem[i])
        conv0 = jnp.zeros((Bp, CONV_BUF, D_CONV), dt)
        shift0 = jnp.zeros((Bp, 1, D_SHIFT), dt)
        wkv0 = jnp.zeros((Bp, RWKV_HEADS, RWKV_HEAD, RWKV_HEAD), jnp.float32)
        hp, cp, sp, wp = _layer(hp, mk, mv, conv0, shift0, wkv0, p)
        hs, cs, ss, ws = _layer(hs, cache_mem_k[i], cache_mem_v[i], state_conv[i], state_shift[i],
                                state_wkv[i], p)
        mk_l.append(mk); mv_l.append(mv); cp_l.append(cp); sp_l.append(sp); wp_l.append(wp)
        cs_l.append(cs); ss_l.append(ss); ws_l.append(ws)
    y_prompt = _rms(hp, g_norm_final)
    y_sample = _rms(hs, g_norm_final)
    mem_k_prompt = jnp.stack(mk_l)
    mem_v_prompt = jnp.stack(mv_l)
    conv_prompt = jnp.stack(cp_l)
    shift_prompt = jnp.stack(sp_l)
    wkv_prompt = jnp.stack(wp_l)
    conv_sample = jnp.stack(cs_l)
    shift_sample = jnp.stack(ss_l)
    wkv_sample = jnp.stack(ws_l)
    return (y_prompt, y_sample, mem_k_prompt, mem_v_prompt, conv_prompt, shift_prompt, wkv_prompt,
            conv_sample, shift_sample, wkv_sample)
```

```cpp
#include <hip/hip_runtime.h>
#include <hip/hip_cooperative_groups.h>
#include <cstdio>
namespace cg = cooperative_groups;

#define LAS __attribute__((address_space(3)))
typedef unsigned short bf16_t;
typedef short bf16x8 __attribute__((ext_vector_type(8)));
typedef float f32x4 __attribute__((ext_vector_type(4)));
typedef unsigned u32x4 __attribute__((ext_vector_type(4)));
typedef unsigned u32x2 __attribute__((ext_vector_type(2)));
typedef float f32x2 __attribute__((ext_vector_type(2)));

constexpr int D = 1024, MP = 32768, MS = 256, M = MP + MS, MPAD = M + 256;
constexpr int DSH = 3328, DCV = 512, DFF = 2816;
constexpr int VTLD = 24 * 256;
constexpr int LDS_ST = 132608, LDS_BYTES = LDS_ST + 64;
constexpr int NPHASE = 16;

constexpr size_t O_MK = (size_t)M * D, O_MV = O_MK + 2048 * 1024, O_CP = O_MV + 2048 * 1024, O_SP = O_CP + 8 * 30 * 512,
                 O_WP = O_SP + 8 * 3328, O_CS = O_WP + 8 * 16 * 4096, O_SS = O_CS + 16 * 30 * 512, O_WS = O_SS + 16 * 3328;

enum { I_XP = 0, I_XS, I_CK, I_CV, I_SCONV, I_SSHIFT, I_SWKV, I_MEM, I_GMIX, I_WIN, I_MU, I_WDW, I_BDW, I_LCG, I_LCB, I_WOC, I_W0, I_WUP, I_A0, I_AUP,
       I_GUP, I_KK, I_KA, I_RK, I_LXG, I_LXB, I_WOR, I_WOUT, I_GX, I_GMEM, I_WQ, I_WK, I_WV, I_WOX, I_GFFN, I_WFG, I_WFU, I_WFD, I_GFIN, N_IN };

struct Params {
    const float* in[N_IN];
    float* out;
    bf16_t *WinT, *WkvT, *Wea, *Wg, *WocT, *WorT, *WoutT, *WqT, *WoxT, *WguT, *WdT, *Kb, *VT;
    float *ss1, *ss2, *ss3, *psum, *rk;
    bf16_t *memn, *xn, *ebuf, *hb, *pr, *hid, *tmp, *q, *merged, *ob, *P, *lin, *u, *ybuf, *abuf, *sconv, *gates;
    unsigned* bar;
    int ph_lo, ph_hi;
};

typedef const __attribute__((address_space(4))) Params CParams;

__device__ __forceinline__ int tid_opaque() { int t = threadIdx.x; asm volatile("" : "+v"(t)); return t; }
__device__ __forceinline__ float bf2f(bf16_t b) { return __uint_as_float(((unsigned)b) << 16); }
__device__ __forceinline__ float bf_lo(unsigned w) { return __uint_as_float(w << 16); }
__device__ __forceinline__ float bf_hi(unsigned w) { return __uint_as_float(w & 0xffff0000u); }
__device__ __forceinline__ unsigned pk2(float lo, float hi) { unsigned r; asm("v_cvt_pk_bf16_f32 %0, %1, %2" : "=v"(r) : "v"(lo), "v"(hi)); return r; }
__device__ __forceinline__ bf16_t f2bf(float f) { return (bf16_t)(pk2(f, 0.f) & 0xffffu); }
__device__ __forceinline__ u32x4 pack8(f32x4 a, f32x4 b) { u32x4 w; w.x = pk2(a[0], a[1]); w.y = pk2(a[2], a[3]); w.z = pk2(b[0], b[1]); w.w = pk2(b[2], b[3]); return w; }
__device__ __forceinline__ void unpack8(u32x4 w, f32x4& a, f32x4& b) { a = (f32x4){bf_lo(w.x), bf_hi(w.x), bf_lo(w.y), bf_hi(w.y)}; b = (f32x4){bf_lo(w.z), bf_hi(w.z), bf_lo(w.w), bf_hi(w.w)}; }
#define NTL(T, ptr) __builtin_nontemporal_load((const T*)(ptr))
#define NTS(T, ptr, val) __builtin_nontemporal_store((val), (T*)(ptr))
__device__ __forceinline__ float sigm(float x) { return 1.f / (1.f + __expf(-x)); }
__device__ __forceinline__ f32x4 sigm4(f32x4 v) { return (f32x4){sigm(v[0]), sigm(v[1]), sigm(v[2]), sigm(v[3])}; }
__device__ __forceinline__ float dot4(f32x4 a, f32x4 b) { return a[0] * b[0] + a[1] * b[1] + a[2] * b[2] + a[3] * b[3]; }
template <int CTRL> __device__ __forceinline__ float dppf(float x) { return __builtin_bit_cast(float, __builtin_amdgcn_mov_dpp(__builtin_bit_cast(int, x), CTRL, 0xf, 0xf, true)); }
__device__ __forceinline__ float reduce8(float x) { x += dppf<0xB1>(x); x += dppf<0x4E>(x); x += dppf<0x141>(x); return x; }
__device__ __forceinline__ float wave_sum(float x) {
    x += dppf<0xB1>(x); x += dppf<0x4E>(x); x += dppf<0x141>(x); x += dppf<0x140>(x);
    x += __builtin_bit_cast(float, __builtin_amdgcn_update_dpp(0, __builtin_bit_cast(int, x), 0x142, 0xa, 0xf, false));
    x += __builtin_bit_cast(float, __builtin_amdgcn_update_dpp(0, __builtin_bit_cast(int, x), 0x143, 0xc, 0xf, false));
    return __builtin_bit_cast(float, __builtin_amdgcn_readlane(__builtin_bit_cast(int, x), 63));
}

#define XB_TMO      128
#define XB_XCNT(j)  (256  + 64 * (j))
#define XB_XSUB(j)  (1280 + 64 * (j))
#define XB_XGEN(j)  (2304 + 64 * (j))
#define XB_TOP      3328
#define XB_TOPGEN   3392
#define XCD_BAR_WORDS 3456
#define XB_SPIN_CAP (1u << 18)

__device__ __forceinline__ unsigned xb_ld(unsigned* p)              { return __hip_atomic_load(p, __ATOMIC_RELAXED, __HIP_MEMORY_SCOPE_AGENT); }
__device__ __forceinline__ unsigned xb_add(unsigned* p, unsigned v) { return __hip_atomic_fetch_add(p, v, __ATOMIC_RELAXED, __HIP_MEMORY_SCOPE_AGENT); }
__device__ __forceinline__ unsigned xb_xcc_id() { return (unsigned)__builtin_amdgcn_s_getreg((3 << 11) | 20) & 0xFu; }
#define XB_SPIN(cond, bar) do { unsigned _sp = 0; while (cond) { __builtin_amdgcn_s_sleep(1); \
    if ((++_sp & 255u) == 0u) { if (xb_ld(&(bar)[XB_TMO])) break; if (_sp > XB_SPIN_CAP) { atomicAdd(&(bar)[XB_TMO], 1u); break; } } } } while (0)

struct XcdBarrier {
    unsigned* bar; unsigned x;
    volatile LAS unsigned* st;
};

__device__ __forceinline__ XcdBarrier xcd_barrier_post(unsigned* bar, volatile LAS unsigned* st) {
    XcdBarrier b; b.bar = bar; b.x = xb_xcc_id(); b.st = st;
    if (threadIdx.x == 0) (void)xb_add(&bar[XB_XCNT(b.x)], 1u);
    return b;
}
__device__ __forceinline__ void xcd_barrier_complete(unsigned* bar, unsigned x, unsigned& nloc, unsigned& nx) {
    const unsigned G = gridDim.x * gridDim.y * gridDim.z;
    unsigned sum, cnt, mine, sp = 0u;
    for (;;) {
        sum = 0u; cnt = 0u; mine = 0u;
#pragma unroll
        for (unsigned j = 0; j < 16; ++j) { const unsigned c = xb_ld(&bar[XB_XCNT(j)]); sum += c; cnt += (c > 0u) ? 1u : 0u; mine = (j == x) ? c : mine; }
        if (sum == G) break;
        __builtin_amdgcn_s_sleep(1);
        if ((++sp & 255u) == 0u) { if (xb_ld(&bar[XB_TMO])) break; if (sp > XB_SPIN_CAP) { atomicAdd(&bar[XB_TMO], 1u); break; } }
    }
    nloc = mine > 0u ? mine : 1u; nx = cnt > 0u ? cnt : 1u;
}

__device__ __forceinline__ void xcd_barrier(const XcdBarrier& b) {
    asm volatile("s_waitcnt vmcnt(0)" ::: "memory");
    __syncthreads();
    if (threadIdx.x == 0) {
        unsigned* bar = b.bar;
        __builtin_amdgcn_s_waitcnt(0);
        unsigned nloc = b.st[0], nx = b.st[1];
        if (nloc == 0u) { xcd_barrier_complete(bar, b.x, nloc, nx); b.st[0] = nloc; b.st[1] = nx; }
        const unsigned old = xb_add(&bar[XB_XSUB(b.x)], 1u);
        const unsigned gen = old / nloc;
        if (old + 1u == (gen + 1u) * nloc) {
            __builtin_amdgcn_fence(__ATOMIC_RELEASE, "agent");
            asm volatile("s_waitcnt vmcnt(0)" ::: "memory");
            const unsigned og = xb_add(&bar[XB_TOP], 1u);
            const unsigned tg = og / nx;
            if (og + 1u == (tg + 1u) * nx) xb_add(&bar[XB_TOPGEN], 1u);
            else XB_SPIN(xb_ld(&bar[XB_TOPGEN]) == tg, bar);
            __builtin_amdgcn_fence(__ATOMIC_ACQUIRE, "agent");
            xb_add(&bar[XB_XGEN(b.x)], 1u);
            asm volatile("s_waitcnt vmcnt(0)" ::: "memory");
        } else {
            XB_SPIN(xb_ld(&bar[XB_XGEN(b.x)]) == gen, bar);
            __builtin_amdgcn_fence(__ATOMIC_ACQUIRE, "agent");
            asm volatile("s_waitcnt vmcnt(0)" ::: "memory");
        }
    }
    __syncthreads();
}

constexpr int BM = 256, BK = 64, HALF = 128, HTB = HALF * BK * 2, NXCD = 8, WGM = 8;
__device__ __forceinline__ int lds_byte(int r, int c) { const int st = (r >> 4) * 2 + (c >> 5), rr = r & 15, cc = c & 31, ob = rr * 64 + cc * 2; return st * 1024 + (ob ^ (((ob >> 9) & 1) << 5)); }
__device__ __forceinline__ void stage_rc(int b, int& R, int& C) { const int st = b / 1024, sb = b % 1024, swz = sb ^ (((sb >> 9) & 1) << 5); R = (st >> 1) * 16 + swz / 64; C = (st & 1) * 32 + (swz % 64) / 2; }
__device__ __forceinline__ int perm32(int rho) { const int n = rho >> 4, i = rho & 15; return 8 * (i >> 2) + 4 * n + (i & 3); }

enum { E_G1 = 0, E_KV, E_VT, E_EA, E_G, E_CONV, E_RWKV, E_OUT, E_Q, E_S, E_PV, E_OX, E_FFN1, E_DOWN, E_DOWN_HALF };
struct Unit { const char* A; const char* B; int row0; int pn; int aux; int kind; };
struct Job { const char* A; const char* B; const char* A2; const char* B2; int lda, ldb, K, Mrows, N, mode, kind; };

struct Sched {
    const char* A; const char* B; const char* A2; const char* B2; size_t tA, tB; int nM, nN, nwg, nstd, G, c, mode, kind;
    __device__ __forceinline__ void init(const Job& j) {
        A = j.A; B = j.B; tA = (size_t)256 * j.lda * 2; tB = (size_t)256 * j.ldb * 2; nM = j.Mrows / 256; nN = j.N / 256; mode = j.mode;
        A2 = j.A2; B2 = j.B2; kind = j.kind; nstd = nM * nN;
        nwg = (mode == 1 || mode == 2) ? 512 : (mode == 3 ? nstd + 96 : (mode == 4 ? 8 : nstd)); G = (int)gridDim.x; c = (int)blockIdx.x;
    }
    __device__ __forceinline__ bool next(int i, Unit& u) const {
        const long L = (long)i * G + c; if (L >= nwg) return false;
        u.kind = kind;
        if (mode == 4) {
            const int pn = (int)L & 3, kh = (int)L >> 2;
            u.A = A + ((size_t)MP * DFF + (size_t)kh * (DFF / 2)) * 2; u.B = B + ((size_t)pn * 256 * DFF + (size_t)kh * (DFF / 2)) * 2; u.row0 = MP; u.pn = pn; u.aux = 256;
        } else if (mode == 3 && L >= nstd) {
            const int idx = (int)L - nstd;
            if (idx < 64) { const int pm = idx >> 3, pn = idx & 7; u.A = A2 + (size_t)pm * tA; u.B = B2 + (size_t)pn * tB; u.row0 = pm * 256; u.pn = pn; u.aux = 256; u.kind = E_KV; }
            else { const int i2 = idx - 64, pm = i2 >> 3, pn = i2 & 7; u.A = B2 + (size_t)(4 + pm) * tB; u.B = A2 + (size_t)pn * tA; u.row0 = pm * 256; u.pn = pn; u.aux = 256; u.kind = E_VT; }
        } else if (mode == 0 || mode == 3) {
            const int nwg = nstd;
            int wgid = (int)L; { const int q = nwg / NXCD, r = nwg % NXCD, xcd = wgid % NXCD, off = wgid / NXCD; wgid = (xcd < r ? xcd * (q + 1) : r * (q + 1) + (xcd - r) * q) + off; }
            const int nig = WGM * nN, gid = wgid / nig, fm = gid * WGM, gsz = (nM - fm) < WGM ? (nM - fm) : WGM;
            const int pm = fm + ((wgid % nig) % gsz), pn = (wgid % nig) / gsz;
            u.A = A + (size_t)pm * tA; u.B = B + (size_t)pn * tB; u.row0 = pm * 256; u.pn = pn; u.aux = 256;
        } else {
            const int tile = (int)L >> 2, h = (int)L & 3; int row0, seq, nv;
            if (tile < 128) { row0 = tile * 256; seq = tile >> 4; nv = 256; } else { const int s = tile - 128; row0 = MP + s * 16; seq = 8 + s; nv = 16; }
            u.A = A + ((size_t)row0 * 1024 + h * 256) * 2;
            u.B = (mode == 1) ? B + ((size_t)seq * 256 * 1024 + h * 256) * 2 : B + ((size_t)h * 256 * VTLD + seq * 256) * 2;
            u.row0 = row0; u.pn = h; u.aux = nv;
        }
        return true;
    }
};


#define FOR_ROWS _Pragma("unroll") for (int ai = 0; ai < 2; ++ai) _Pragma("unroll") for (int m = 0; m < 4; ++m)
#define ROWDEF const int rt = ai * 128 + wr * 64 + m * 16 + fr; const size_t row = (size_t)u.row0 + rt; (void)rt;

__device__ __forceinline__ void epilogue(const int kind, CParams& p, const f32x4 (&acc)[2][2][4][2], const Unit& u, const int wr, const int wc, const int fr_in, const int fq_in) {
    int fr = fr_in, fq = fq_in; asm volatile("" : "+v"(fr), "+v"(fq));
    const int cw = wc * 32 + 8 * fq;
    switch (kind) {
    case E_G1: {
        if (u.pn < 4) {
            FOR_ROWS { ROWDEF
                const f32x4 a0 = acc[ai][0][m][0], a1 = acc[ai][0][m][1], b0 = sigm4(acc[ai][1][m][0]), b1 = sigm4(acc[ai][1][m][1]);
                *(u32x4*)(p.u + row * DCV + u.pn * 128 + cw) = pack8(a0 * b0, a1 * b1); }
        } else if (u.pn < 17) {
            FOR_ROWS { ROWDEF
#pragma unroll
                for (int bj = 0; bj < 2; ++bj) NTS(u32x4, p.pr + row * DSH + (u.pn - 4) * 256 + bj * 128 + cw, pack8(acc[ai][bj][m][0], acc[ai][bj][m][1])); }
        } else {
            FOR_ROWS { ROWDEF
#pragma unroll
                for (int bj = 0; bj < 2; ++bj) NTS(u32x4, p.gates + row * 2048 + (u.pn - 17) * 256 + bj * 128 + cw, pack8(sigm4(acc[ai][bj][m][0]), sigm4(acc[ai][bj][m][1]))); }
        }
    } break;
    case E_KV: {
        FOR_ROWS { ROWDEF
#pragma unroll
            for (int bj = 0; bj < 2; ++bj) {
                const int col = (u.pn & 3) * 256 + bj * 128 + cw;
                float* o = p.out + (u.pn < 4 ? O_MK : O_MV) + row * 1024 + col;
                NTS(f32x4, o, acc[ai][bj][m][0]); NTS(f32x4, o + 4, acc[ai][bj][m][1]);
                if (u.pn < 4) *(u32x4*)(p.Kb + row * 1024 + col) = pack8(acc[ai][bj][m][0], acc[ai][bj][m][1]);
            } }
    } break;
    case E_VT: {
        FOR_ROWS { ROWDEF
#pragma unroll
            for (int bj = 0; bj < 2; ++bj) *(u32x4*)(p.VT + row * VTLD + u.pn * 256 + bj * 128 + cw) = pack8(acc[ai][bj][m][0], acc[ai][bj][m][1]); }
    } break;
    case E_EA: {
        const float* bias = u.pn < 4 ? p.in[I_W0] : p.in[I_A0];
        bf16_t* o = u.pn < 4 ? p.ebuf : p.abuf;
        const float sc = u.pn < 4 ? 0.60653066f : 1.0f;
        f32x4 bv[2][2];
#pragma unroll
        for (int bj = 0; bj < 2; ++bj) { const int col = (u.pn & 3) * 256 + bj * 128 + cw; bv[bj][0] = *(const f32x4*)(bias + col); bv[bj][1] = *(const f32x4*)(bias + col + 4); }
        FOR_ROWS { ROWDEF
#pragma unroll
            for (int bj = 0; bj < 2; ++bj) {
                const int col = (u.pn & 3) * 256 + bj * 128 + cw;
                *(u32x4*)(o + row * 1024 + col) = pack8(sigm4(acc[ai][bj][m][0] + bv[bj][0]) * sc, sigm4(acc[ai][bj][m][1] + bv[bj][1]) * sc);
            } }
    } break;
    case E_G: {
#pragma unroll
        for (int ai = 0; ai < 2; ++ai) {
            u32x4 yv[4][2];
#pragma unroll
            for (int m = 0; m < 4; ++m) { ROWDEF
#pragma unroll
                for (int bj = 0; bj < 2; ++bj) yv[m][bj] = *(const u32x4*)(p.ybuf + row * 1024 + u.pn * 256 + bj * 128 + cw); }
#pragma unroll
            for (int m = 0; m < 4; ++m) { ROWDEF
#pragma unroll
                for (int bj = 0; bj < 2; ++bj) { f32x4 y0, y1; unpack8(yv[m][bj], y0, y1);
                    *(u32x4*)(p.ybuf + row * 1024 + u.pn * 256 + bj * 128 + cw) = pack8(y0 * acc[ai][bj][m][0], y1 * acc[ai][bj][m][1]); } }
        }
    } break;
    case E_CONV: {
#pragma unroll
        for (int ai = 0; ai < 2; ++ai) {
            u32x4 gv[4][2];
#pragma unroll
            for (int m = 0; m < 4; ++m) { ROWDEF
#pragma unroll
                for (int bj = 0; bj < 2; ++bj) gv[m][bj] = NTL(u32x4, p.gates + row * 2048 + u.pn * 256 + bj * 128 + cw); }
#pragma unroll
            for (int m = 0; m < 4; ++m) { ROWDEF
#pragma unroll
                for (int bj = 0; bj < 2; ++bj) { f32x4 g0, g1; unpack8(gv[m][bj], g0, g1);
                    *(u32x4*)(p.tmp + row * 1024 + u.pn * 256 + bj * 128 + cw) = pack8(g0 * acc[ai][bj][m][0], g1 * acc[ai][bj][m][1]); } }
        }
    } break;
    case E_RWKV: {
#pragma unroll
        for (int ai = 0; ai < 2; ++ai)
#pragma unroll
        for (int mh = 0; mh < 2; ++mh) {
            u32x4 gv[2][2], tv[2][2];
#pragma unroll
            for (int mm = 0; mm < 2; ++mm) { const int m = mh * 2 + mm; ROWDEF
#pragma unroll
                for (int bj = 0; bj < 2; ++bj) { const int col = u.pn * 256 + bj * 128 + cw; gv[mm][bj] = NTL(u32x4, p.gates + row * 2048 + 1024 + col); tv[mm][bj] = *(const u32x4*)(p.tmp + row * 1024 + col); } }
#pragma unroll
            for (int mm = 0; mm < 2; ++mm) { const int m = mh * 2 + mm; ROWDEF
#pragma unroll
                for (int bj = 0; bj < 2; ++bj) { f32x4 g0, g1, t0, t1; unpack8(gv[mm][bj], g0, g1); unpack8(tv[mm][bj], t0, t1);
                    *(u32x4*)(p.merged + row * 1024 + u.pn * 256 + bj * 128 + cw) = pack8(t0 + g0 * acc[ai][bj][m][0], t1 + g1 * acc[ai][bj][m][1]); } }
        }
    } break;
    case E_OUT: case E_OX: case E_DOWN: {
        float* ss = kind == E_OUT ? p.ss1 : (kind == E_OX ? p.ss2 : p.ss3);
#pragma unroll
        for (int ai = 0; ai < 2; ++ai)
#pragma unroll
        for (int mh = 0; mh < 2; ++mh) {
            f32x4 rv[2][2][2];
#pragma unroll
            for (int mm = 0; mm < 2; ++mm) { const int m = mh * 2 + mm; ROWDEF
                const float* rp = (kind == E_OUT) ? (row < (size_t)MP ? p.in[I_XP] + row * 1024 : p.in[I_XS] + (row - MP) * 1024) : p.out + row * 1024;
#pragma unroll
                for (int bj = 0; bj < 2; ++bj) { const int col = u.pn * 256 + bj * 128 + cw; rv[mm][bj][0] = NTL(f32x4, rp + col); rv[mm][bj][1] = NTL(f32x4, rp + col + 4); } }
#pragma unroll
            for (int mm = 0; mm < 2; ++mm) { const int m = mh * 2 + mm; ROWDEF
                float s = 0.f;
#pragma unroll
                for (int bj = 0; bj < 2; ++bj) {
                    const int col = u.pn * 256 + bj * 128 + cw;
                    const f32x4 h0 = rv[mm][bj][0] + acc[ai][bj][m][0], h1 = rv[mm][bj][1] + acc[ai][bj][m][1];
                    *(f32x4*)(p.out + row * 1024 + col) = h0; *(f32x4*)(p.out + row * 1024 + col + 4) = h1;
                    if (kind != E_DOWN) *(u32x4*)(p.hb + row * 1024 + col) = pack8(h0, h1);
                    s += dot4(h0, h0) + dot4(h1, h1);
                }
                if (kind != E_DOWN) { s += __shfl_xor(s, 16); s += __shfl_xor(s, 32); if (fq == 0) unsafeAtomicAdd(ss + row, s); }
            }
        }
    } break;
    case E_DOWN_HALF: {
        FOR_ROWS { ROWDEF
#pragma unroll
            for (int bj = 0; bj < 2; ++bj) { float* hp = p.out + row * 1024 + u.pn * 256 + bj * 128 + cw;
#pragma unroll
                for (int j = 0; j < 4; ++j) { unsafeAtomicAdd(hp + j, acc[ai][bj][m][0][j]); unsafeAtomicAdd(hp + 4 + j, acc[ai][bj][m][1][j]); } } }
    } break;
    case E_Q: {
        float rsv[2][4];
        FOR_ROWS { ROWDEF rsv[ai][m] = p.ss1[row]; }
        FOR_ROWS { ROWDEF
            const float rs = rsqrtf(rsv[ai][m] * (1.f / 1024.f) + 1e-6f);
#pragma unroll
            for (int bj = 0; bj < 2; ++bj) *(u32x4*)(p.q + row * 1024 + u.pn * 256 + bj * 128 + cw) = pack8(acc[ai][bj][m][0] * rs, acc[ai][bj][m][1] * rs);
        }
    } break;
    case E_S: {
        FOR_ROWS { ROWDEF
            float s = 0.f;
#pragma unroll
            for (int bj = 0; bj < 2; ++bj) {
                f32x4 e0, e1;
#pragma unroll
                for (int j = 0; j < 4; ++j) { e0[j] = __expf(acc[ai][bj][m][0][j] * 0.0625f); e1[j] = __expf(acc[ai][bj][m][1][j] * 0.0625f); }
                const u32x4 w = pack8(e0, e1);
                f32x4 r0, r1; unpack8(w, r0, r1);
                s += (r0[0] + r0[1]) + (r0[2] + r0[3]) + (r1[0] + r1[1]) + (r1[2] + r1[3]);
                if (rt < u.aux) *(u32x4*)(p.P + row * 1024 + u.pn * 256 + bj * 128 + cw) = w;
            }
            s += __shfl_xor(s, 16); s += __shfl_xor(s, 32);
            if (fq == 0 && rt < u.aux) unsafeAtomicAdd(p.psum + row * 4 + u.pn, s);
        }
    } break;
    case E_PV: {
        float pv[2][4];
        FOR_ROWS { ROWDEF pv[ai][m] = __hip_atomic_load(p.psum + (rt < u.aux ? row : (size_t)u.row0) * 4 + u.pn, __ATOMIC_RELAXED, __HIP_MEMORY_SCOPE_AGENT); }
        FOR_ROWS { ROWDEF
            if (rt < u.aux) {
                const float inv = 1.f / pv[ai][m];
#pragma unroll
                for (int bj = 0; bj < 2; ++bj) *(u32x4*)(p.ob + row * 1024 + u.pn * 256 + bj * 128 + cw) = pack8(acc[ai][bj][m][0] * inv, acc[ai][bj][m][1] * inv);
            }
        }
    } break;
    case E_FFN1: {
        float rsv[2][4];
        FOR_ROWS { ROWDEF rsv[ai][m] = p.ss2[row]; }
        FOR_ROWS { ROWDEF
            const float rs = rsqrtf(rsv[ai][m] * (1.f / 1024.f) + 1e-6f);
            const f32x4 g0 = acc[ai][0][m][0] * rs, g1 = acc[ai][0][m][1] * rs, u0 = acc[ai][1][m][0] * rs, u1 = acc[ai][1][m][1] * rs;
            *(u32x4*)(p.hid + row * DFF + u.pn * 128 + cw) = pack8(g0 * sigm4(g0) * u0, g1 * sigm4(g1) * u1);
        }
    } break;
    default: break;
    }
}

__device__ __forceinline__ void gemm_phase(LAS unsigned char* lds, CParams& p, const Job& jb) {
    const int tid = tid_opaque(), wid = __builtin_amdgcn_readfirstlane(tid >> 6), lane = tid & 63, wr = wid >> 2, wc = wid & 3, fr = lane & 15, fq = lane >> 4;
    Sched S; S.init(jb);
    const int K = jb.K, nt = K / BK, lda = jb.lda, ldb = jb.ldb;
    unsigned voffA[2], voffB[2];
#pragma unroll
    for (int i = 0; i < 2; ++i) { int R, C; stage_rc(tid * 16 + i * 8192, R, C); const int Rb = (R & ~31) + perm32(R & 31);
        voffA[i] = (unsigned)(R * lda + C) * 2u; voffB[i] = (unsigned)(Rb * ldb + C) * 2u; }
    const size_t kstep = (size_t)(BK * 2);
    const size_t hstepA = (size_t)HALF * lda * 2, hstepB = (size_t)HALF * ldb * 2;
    const unsigned ldsw = (unsigned)wid * 1024u;
    const int aoff = lds_byte(wr * 64 + fr, fq * 8), boff = lds_byte(wc * 32 + fr, fq * 8);
#define PG8_SA(b, h) (((b) * 2 + (h)) * HTB)
#define PG8_SB(b, h) ((4 + (b) * 2 + (h)) * HTB)
#define PG8_STAGE(bufoff, gbase, voff) do { _Pragma("unroll") for (int _i = 0; _i < 2; ++_i) \
        __builtin_amdgcn_global_load_lds((const unsigned*)((const char*)(gbase) + (voff)[_i]), (LAS unsigned*)(lds + (bufoff) + ldsw + _i * 8192), 16, 0, 0); } while (0)
#define PG8_LDA(dst, b, h) do { _Pragma("unroll") for (int m = 0; m < 4; ++m) _Pragma("unroll") for (int k = 0; k < 2; ++k) dst[m][k] = *(const LAS bf16x8*)(lds + PG8_SA(b, h) + aoff + m * 2048 + k * 1024); } while (0)
#define PG8_LDB(dst, b, h) do { _Pragma("unroll") for (int n = 0; n < 2; ++n) _Pragma("unroll") for (int k = 0; k < 2; ++k) dst[n][k] = *(const LAS bf16x8*)(lds + PG8_SB(b, h) + boff + n * 2048 + k * 1024); } while (0)
#define PG8_MMA(ai, bj, At, Bt) do { __builtin_amdgcn_s_setprio(1); _Pragma("unroll") for (int m = 0; m < 4; ++m) _Pragma("unroll") for (int n = 0; n < 2; ++n) _Pragma("unroll") for (int k = 0; k < 2; ++k) \
        acc[ai][bj][m][n] = __builtin_amdgcn_mfma_f32_16x16x32_bf16(Bt[n][k], At[m][k], acc[ai][bj][m][n], 0, 0, 0); __builtin_amdgcn_s_setprio(0); } while (0)
#define PG8_WAIT_V(n) asm volatile("s_waitcnt vmcnt(" #n ")" ::: "memory")
#define PG8_WAIT_L(n) asm volatile("s_waitcnt lgkmcnt(" #n ")" ::: "memory")
#define PG8_BAR __builtin_amdgcn_s_barrier()
#define PG8_SCHED __builtin_amdgcn_sched_barrier(0)
    Unit cur, nxt; int ui = 0;
    if (!S.next(0, cur)) return;
    f32x4 acc[2][2][4][2];
#pragma unroll
    for (int a = 0; a < 2; ++a)
#pragma unroll
        for (int b = 0; b < 2; ++b)
#pragma unroll
            for (int m = 0; m < 4; ++m)
#pragma unroll
                for (int n = 0; n < 2; ++n) acc[a][b][m][n] = (f32x4){0.f, 0.f, 0.f, 0.f};
    bf16x8 At[4][2], B0[2][2], B1[2][2];
    const char* cA = cur.A; const char* cB = cur.B;
    PG8_STAGE(PG8_SB(0, 0), cB, voffB); PG8_STAGE(PG8_SA(0, 0), cA, voffA); PG8_STAGE(PG8_SB(0, 1), cB + hstepB, voffB); PG8_STAGE(PG8_SA(0, 1), cA + hstepA, voffA);
    if (wr == 1) PG8_BAR;
    PG8_WAIT_V(4); PG8_BAR;
    PG8_STAGE(PG8_SB(1, 0), cB + kstep, voffB); PG8_STAGE(PG8_SA(1, 0), cA + kstep, voffA); PG8_STAGE(PG8_SB(1, 1), cB + hstepB + kstep, voffB);
    PG8_WAIT_V(6); PG8_BAR;
    for (;;) {
        const bool has_next = S.next(ui + 1, nxt);
        const char* nA = has_next ? nxt.A : cA; const char* nB = has_next ? nxt.B : cB;
        for (int t = 0; t < nt; t += 2) {
            const bool last = (t == nt - 2);
            const char* a1 = cA + (size_t)(t + 1) * kstep;
            const char* a2 = last ? nA : cA + (size_t)(t + 2) * kstep; const char* b2 = last ? nB : cB + (size_t)(t + 2) * kstep;
            const char* a3 = a2 + kstep; const char* b3 = b2 + kstep;
            PG8_LDB(B0, 0, 0); PG8_SCHED; PG8_LDA(At, 0, 0); PG8_STAGE(PG8_SA(1, 1), a1 + hstepA, voffA);
            PG8_WAIT_L(8); PG8_BAR; PG8_WAIT_L(0); PG8_MMA(0, 0, At, B0); PG8_BAR; PG8_SCHED;
            PG8_LDB(B1, 0, 1); PG8_STAGE(PG8_SB(0, 0), b2, voffB);
            PG8_BAR; PG8_WAIT_L(0); PG8_MMA(0, 1, At, B1); PG8_BAR;
            PG8_LDA(At, 0, 1); PG8_STAGE(PG8_SA(0, 0), a2, voffA);
            PG8_BAR; PG8_WAIT_L(0); PG8_MMA(1, 0, At, B0); PG8_BAR; PG8_SCHED;
            PG8_STAGE(PG8_SB(0, 1), b2 + hstepB, voffB);
            PG8_WAIT_V(6); PG8_BAR; PG8_MMA(1, 1, At, B1); PG8_BAR;
            PG8_LDB(B0, 1, 0); PG8_SCHED; PG8_LDA(At, 1, 0); PG8_STAGE(PG8_SA(0, 1), a2 + hstepA, voffA);
            PG8_WAIT_L(8); PG8_BAR; PG8_WAIT_L(0); PG8_MMA(0, 0, At, B0); PG8_BAR; PG8_SCHED;
            PG8_LDB(B1, 1, 1); PG8_STAGE(PG8_SB(1, 0), b3, voffB);
            PG8_BAR; PG8_WAIT_L(0); PG8_MMA(0, 1, At, B1); PG8_BAR;
            PG8_LDA(At, 1, 1); PG8_STAGE(PG8_SA(1, 0), a3, voffA);
            PG8_BAR; PG8_WAIT_L(0); PG8_MMA(1, 0, At, B0); PG8_BAR; PG8_SCHED;
            PG8_STAGE(PG8_SB(1, 1), b3 + hstepB, voffB);
            PG8_WAIT_V(6); PG8_BAR; PG8_MMA(1, 1, At, B1); PG8_BAR;
        }
        epilogue(cur.kind, p, acc, cur, wr, wc, fr, fq);
        if (!has_next) break;
#pragma unroll
        for (int a = 0; a < 2; ++a)
#pragma unroll
            for (int b = 0; b < 2; ++b)
#pragma unroll
                for (int m = 0; m < 4; ++m)
#pragma unroll
                    for (int n = 0; n < 2; ++n) acc[a][b][m][n] = (f32x4){0.f, 0.f, 0.f, 0.f};
        cur = nxt; cA = nA; cB = nB; ++ui;
    }
    PG8_WAIT_V(0);
    if (wr == 0) PG8_BAR;
    PG8_BAR;
}

__device__ __forceinline__ void convT(LAS float* tile, const float* src, const float* src2, int ldsrc, int K, int N, bf16_t* dst, int lddst, const float* scale, int mode) {
    const int tid = tid_opaque(), ntk = K / 64, ntn = N / 64, ntiles = ntk * ntn;
    float v[8];
    auto load_tile = [&](int t) {
        const int kt = t % ntk, nt_ = t / ntk, k0 = kt * 64, n0 = nt_ * 64;
        const float* s = src; int sc0 = n0;
        if (mode == 1 && n0 < 1024) { const int pn = n0 >> 8, w = n0 & 255, bj = w >> 7, c = w & 127; sc0 = bj * 512 + pn * 128 + c; }
        if (mode == 2) { const int pn = n0 >> 8, bj = (n0 >> 7) & 1, c = n0 & 127; sc0 = pn * 128 + c; s = bj ? src2 : src; }
#pragma unroll
        for (int i = 0; i < 8; ++i) { const int k = i * 8 + (tid >> 6), n = tid & 63;
            float x = __builtin_nontemporal_load(s + (size_t)(k0 + k) * ldsrc + sc0 + n); if (scale) x *= scale[k0 + k];
            v[i] = x; }
    };
    int t = blockIdx.x;
    if (t < ntiles) load_tile(t);
    for (; t < ntiles; t += gridDim.x) {
        const int kt = t % ntk, nt_ = t / ntk, k0 = kt * 64, n0 = nt_ * 64;
#pragma unroll
        for (int i = 0; i < 8; ++i) tile[(i * 8 + (tid >> 6)) * 65 + (tid & 63)] = v[i];
        __syncthreads();
        if (t + (int)gridDim.x < ntiles) load_tile(t + gridDim.x);
        { const int n = tid >> 3, kg = tid & 7; f32x4 a, b;
#pragma unroll
          for (int j = 0; j < 4; ++j) { a[j] = tile[(kg * 8 + j) * 65 + n]; b[j] = tile[(kg * 8 + 4 + j) * 65 + n]; }
          *(u32x4*)(dst + (size_t)(n0 + n) * lddst + k0 + kg * 8) = pack8(a, b); }
        __syncthreads();
    }
}

__device__ __forceinline__ void phase_prep(CParams& p, LAS unsigned char* lds) {
    const int tid = tid_opaque(), wid = tid >> 6, lane = tid & 63;
    const int gw = blockIdx.x * 8 + wid, nw = gridDim.x * 8;
    const size_t gt = (size_t)blockIdx.x * 512 + tid, ntot = (size_t)gridDim.x * 512;
    for (int row0 = gw; row0 < M + 2048; row0 += 2 * nw) {
        f32x4 v[2][4]; float ssq[2];
#pragma unroll
        for (int b = 0; b < 2; ++b) { const int rr = row0 + b * nw, row = rr < M + 2048 ? rr : row0;
            const float* src = row < MP ? p.in[I_XP] + (size_t)row * 1024 : (row < M ? p.in[I_XS] + (size_t)(row - MP) * 1024 : p.in[I_MEM] + (size_t)(row - M) * 1024);
#pragma unroll
            for (int i = 0; i < 4; ++i) v[b][i] = __builtin_nontemporal_load((const f32x4*)(src + lane * 4 + i * 256)); }
#pragma unroll
        for (int b = 0; b < 2; ++b) { float s = 0.f;
#pragma unroll
            for (int i = 0; i < 4; ++i) s += dot4(v[b][i], v[b][i]);
            ssq[b] = wave_sum(s); }
#pragma unroll
        for (int b = 0; b < 2; ++b) { const int row = row0 + b * nw;
            if (row < M + 2048) {
                bf16_t* dst = row < M ? p.xn + (size_t)row * 1024 : p.memn + (size_t)(row - M) * 1024;
                const float rs = rsqrtf(ssq[b] * (1.f / 1024.f) + 1e-6f);
#pragma unroll
                for (int i = 0; i < 4; ++i) { u32x2 w; w.x = pk2(v[b][i][0] * rs, v[b][i][1] * rs); w.y = pk2(v[b][i][2] * rs, v[b][i][3] * rs); *(u32x2*)(dst + lane * 4 + i * 256) = w; } } }
    }
    LAS float* tile = (LAS float*)lds;
    convT(tile, p.in[I_WIN], nullptr, 6400, 1024, 6400, p.WinT, 1024, p.in[I_GMIX], 1);
    convT(tile, p.in[I_WK], nullptr, 1024, 1024, 1024, p.WkvT, 1024, p.in[I_GMEM], 0);
    convT(tile, p.in[I_WV], nullptr, 1024, 1024, 1024, p.WkvT + (size_t)1024 * 1024, 1024, p.in[I_GMEM], 0);
    convT(tile, p.in[I_CV], nullptr, 1024, 16 * 256, 1024, p.VT + 8 * 256, VTLD, nullptr, 0);
    for (size_t i = gt; i < (size_t)16 * 256 * 1024 / 4; i += ntot) { const f32x4 v = NTL(f32x4, p.in[I_CK] + i * 4); u32x2 w; w.x = pk2(v[0], v[1]); w.y = pk2(v[2], v[3]); *(u32x2*)(p.Kb + (size_t)8 * 256 * 1024 + i * 4) = w; }
    for (size_t i = gt; i < (size_t)3072 * 128; i += ntot) { const int n = (int)(i >> 7), k = (int)(i & 127); float v = 0.f; bf16_t* d;
        if (n < 1024) { if (k < 64) v = p.in[I_WUP][k * 1024 + n]; d = p.Wea + i; }
        else if (n < 2048) { if (k >= 64) v = p.in[I_AUP][(k - 64) * 1024 + (n - 1024)]; d = p.Wea + i; }
        else { v = p.in[I_GUP][k * 1024 + (n - 2048)]; d = p.Wg + (i - (size_t)2048 * 128); }
        *d = f2bf(v); }
    if (blockIdx.x == 0) for (int i = tid; i < XCD_BAR_WORDS; i += 512) p.bar[i] = 0u;
    for (size_t i = gt; i < (size_t)M; i += ntot) { p.ss1[i] = 0.f; p.ss2[i] = 0.f; p.ss3[i] = 0.f; }
    for (size_t i = gt; i < (size_t)M * 4; i += ntot) p.psum[i] = 0.f;
}

__device__ __forceinline__ void phase_conv(CParams& p, LAS unsigned char* lds) {
    const int tid = tid_opaque(), wid = tid >> 6, lane = tid & 63;
    const int gw = blockIdx.x * 8 + wid, nw = gridDim.x * 8;
    const size_t gt = (size_t)blockIdx.x * 512 + tid, ntot = (size_t)gridDim.x * 512;
    LAS float* wl = (LAS float*)lds;
    for (int i = tid; i < 31 * 512; i += 512) wl[i] = p.in[I_WDW][i];
    __syncthreads();
    const int ch0 = lane * 8;
    const f32x4 bd0 = *(const f32x4*)(p.in[I_BDW] + ch0), bd1 = *(const f32x4*)(p.in[I_BDW] + ch0 + 4);
    const f32x4 lg0 = *(const f32x4*)(p.in[I_LCG] + ch0), lg1 = *(const f32x4*)(p.in[I_LCG] + ch0 + 4);
    const f32x4 lb0 = *(const f32x4*)(p.in[I_LCB] + ch0), lb1 = *(const f32x4*)(p.in[I_LCB] + ch0 + 4);
    auto finish = [&](f32x4 c0, f32x4 c1, int mm) {
        const float mean = wave_sum((c0[0] + c0[1]) + (c0[2] + c0[3]) + (c1[0] + c1[1]) + (c1[2] + c1[3])) * (1.f / 512.f);
        c0 -= mean; c1 -= mean;
        const float var = wave_sum(dot4(c0, c0) + dot4(c1, c1)) * (1.f / 512.f);
        const float rstd = rsqrtf(var + 1e-5f);
        c0 = c0 * rstd * lg0 + lb0; c1 = c1 * rstd * lg1 + lb1;
        *(u32x4*)(p.sconv + (size_t)mm * DCV + ch0) = pack8(c0 * sigm4(c0), c1 * sigm4(c1));
    };
    auto boundary_token = [&](const int mm, const int tt, const int sidx, const bool prompt) {
        f32x4 c0 = bd0, c1 = bd1;
#pragma unroll 1
        for (int j0 = 0; j0 < 32; j0 += 8) {
            u32x4 xr[8]; f32x4 s0[8], s1[8];
#pragma unroll
            for (int jj = 0; jj < 8; ++jj) { const int j = j0 + jj; const bool ok = j < 31 && tt + j >= 30; xr[jj] = *(const u32x4*)(p.u + (size_t)(ok ? mm + j - 30 : mm) * DCV + ch0); }
            if (!prompt) {
#pragma unroll
                for (int jj = 0; jj < 8; ++jj) { const int j = j0 + jj, i = tt + j; const bool ok = j < 31 && i < 30;
                    const float* sp = p.in[I_SCONV] + ((size_t)sidx * 30 + (ok ? i : 0)) * 512 + ch0; s0[jj] = *(const f32x4*)sp; s1[jj] = *(const f32x4*)(sp + 4); }
            }
#pragma unroll
            for (int jj = 0; jj < 8; ++jj) { const int j = j0 + jj; const float f = (j < 31 && tt + j >= 30) ? 1.f : 0.f; const int jc = j < 31 ? j : 30; f32x4 x0, x1; unpack8(xr[jj], x0, x1);
                const f32x4 w0 = *(const LAS f32x4*)(wl + jc * 512 + ch0), w1 = *(const LAS f32x4*)(wl + jc * 512 + ch0 + 4);
                c0 += x0 * (w0 * f); c1 += x1 * (w1 * f);
                if (!prompt) { const float g = (j < 31 && tt + j < 30) ? 1.f : 0.f; c0 += s0[jj] * (w0 * g); c1 += s1[jj] * (w1 * g); } }
        }
        finish(c0, c1, mm);
    };
    for (int mp = gw; mp < MP / 2; mp += nw) {
        const int m = mp * 2, t = m & 4095;
        if (t >= 30) {
            u32x4 xr[32];
            const bf16_t* up = p.u + (size_t)(m - 30) * DCV + ch0;
#pragma unroll
            for (int j = 0; j < 32; ++j) xr[j] = *(const u32x4*)(up + (size_t)j * DCV);
            f32x4 a0 = bd0, a1 = bd1, b0 = bd0, b1 = bd1, x0, x1, y0, y1;
            unpack8(xr[0], x0, x1);
#pragma unroll
            for (int j = 0; j < 31; ++j) {
                unpack8(xr[j + 1], y0, y1);
                const f32x4 w0 = *(const LAS f32x4*)(wl + j * 512 + ch0), w1 = *(const LAS f32x4*)(wl + j * 512 + ch0 + 4);
                a0 += x0 * w0; a1 += x1 * w1; b0 += y0 * w0; b1 += y1 * w1;
                x0 = y0; x1 = y1;
            }
            finish(a0, a1, m); finish(b0, b1, m + 1);
        } else { boundary_token(m, t, 0, true); boundary_token(m + 1, t + 1, 0, true); }
    }
    for (int st = wid * (int)gridDim.x + (int)blockIdx.x; st < MS; st += nw) boundary_token(MP + st, st & 15, st >> 4, false);
    for (size_t i = gt; i < (size_t)8 * 30 * 512; i += ntot) { const int ch = (int)(i & 511), r = (int)((i >> 9) % 30), b = (int)(i / (30 * 512));
        p.out[O_CP + i] = bf2f(p.u[((size_t)b * 4096 + 4066 + r) * DCV + ch]); }
    for (size_t i = gt; i < (size_t)16 * 30 * 512; i += ntot) { const int ch = (int)(i & 511), r = (int)((i >> 9) % 30), s = (int)(i / (30 * 512));
        p.out[O_CS + i] = r < 14 ? p.in[I_SCONV][((size_t)s * 30 + 16 + r) * 512 + ch] : bf2f(p.u[((size_t)MP + s * 16 + (r - 14)) * DCV + ch]); }
    for (size_t i = gt; i < (size_t)24 * DSH; i += ntot) { const int sq = (int)(i / DSH), c = (int)(i % DSH);
        if (sq < 8) p.out[O_SP + i] = bf2f(p.pr[((size_t)sq * 4096 + 4095) * DSH + c]);
        else p.out[O_SS + (i - (size_t)8 * DSH)] = bf2f(p.pr[((size_t)MP + (sq - 8) * 16 + 15) * DSH + c]); }
    for (size_t it = gt; it < (size_t)M * 32; it += ntot) {
        const int m = (int)(it >> 5), c8 = (int)(it & 31) * 8, col = 3072 + c8;
        const bool prompt = m < MP; const int t = prompt ? (m & 4095) : ((m - MP) & 15); const int s = prompt ? 0 : ((m - MP) >> 4);
        f32x4 x0, x1, q0, q1;
        unpack8(*(const u32x4*)(p.pr + (size_t)m * DSH + col), x0, x1);
        if (t > 0) unpack8(*(const u32x4*)(p.pr + (size_t)(m - 1) * DSH + col), q0, q1);
        else if (!prompt) { const float* sp = p.in[I_SSHIFT] + (size_t)s * DSH + col; q0 = *(const f32x4*)sp; q1 = *(const f32x4*)(sp + 4); }
        else { q0 = (f32x4){0.f, 0.f, 0.f, 0.f}; q1 = q0; }
        const f32x4 m0 = *(const f32x4*)(p.in[I_MU] + col), m1 = *(const f32x4*)(p.in[I_MU] + col + 4);
        x0 = x0 + (q0 - x0) * m0; x1 = x1 + (q1 - x1) * m1;
        if (c8 < 64) {
#pragma unroll
            for (int j = 0; j < 4; ++j) { x0[j] = tanhf(x0[j]); x1[j] = tanhf(x1[j]); }
        } else if (c8 >= 128) { x0 = sigm4(x0); x1 = sigm4(x1); }
        *(u32x4*)(p.lin + (size_t)m * 256 + c8) = pack8(x0, x1);
    }
}

struct LRaw { u32x4 r0, k0, v0, r1, k1, v1, a, e; };
struct ScanOps { f32x4 r0, r1, w0, w1, k0, k1, n0, n1, b0, b1; float v; };
__device__ __forceinline__ void scan_ld(ScanOps& o, const LAS float* sl, const LAS float* vp) {
    o.r0 = *(const LAS f32x4*)(sl); o.r1 = *(const LAS f32x4*)(sl + 32); o.w0 = *(const LAS f32x4*)(sl + 64); o.w1 = *(const LAS f32x4*)(sl + 96);
    o.k0 = *(const LAS f32x4*)(sl + 128); o.k1 = *(const LAS f32x4*)(sl + 160); o.n0 = *(const LAS f32x4*)(sl + 192); o.n1 = *(const LAS f32x4*)(sl + 224);
    o.b0 = *(const LAS f32x4*)(sl + 256); o.b1 = *(const LAS f32x4*)(sl + 288); o.v = *vp;
}
constexpr int SCH = 32, SBUF = SCH * 1536;
constexpr int YP_OFF = 2 * SBUF + 1536, YP_BYTES = 16 * 1024;
__device__ __forceinline__ void phase_scan(CParams& p, LAS unsigned char* lds) {
    const int tid = tid_opaque(), wid = __builtin_amdgcn_readfirstlane(tid >> 6), lane = tid & 63;
    const bool loader = wid >= 4;
    for (int item = blockIdx.x; item < 768; item += gridDim.x) {
        const bool prompt = item < 256; const int it = prompt ? item : item - 256; const int chain = it >> 1, hf = it & 1;
        const int b = chain >> 4, h = chain & 15;
        const int T = prompt ? 4096 : 16; const size_t m0 = prompt ? (size_t)b * 4096 : (size_t)MP + b * 16;
        const int nch = (T + SCH - 1) / SCH;
        if (loader) {
            const int lw = wid - 4, sl = lane >> 3, g = lane & 7, ch0 = h * 64 + 8 * g;
            const float* mu = p.in[I_MU];
            const f32x4 mur0 = *(const f32x4*)(mu + ch0), mur1 = *(const f32x4*)(mu + ch0 + 4), muk0 = *(const f32x4*)(mu + 1024 + ch0), muk1 = *(const f32x4*)(mu + 1024 + ch0 + 4),
                        muv0 = *(const f32x4*)(mu + 2048 + ch0), muv1 = *(const f32x4*)(mu + 2048 + ch0 + 4);
            const f32x4 kkc0 = *(const f32x4*)(p.in[I_KK] + ch0), kkc1 = *(const f32x4*)(p.in[I_KK] + ch0 + 4), kac0 = *(const f32x4*)(p.in[I_KA] + ch0), kac1 = *(const f32x4*)(p.in[I_KA] + ch0 + 4),
                        rkc0 = *(const f32x4*)(p.in[I_RK] + ch0), rkc1 = *(const f32x4*)(p.in[I_RK] + ch0 + 4);
            LRaw cur, nxt;
            auto load_chunk = [&](int c, LRaw& L) {
                const int t = c * SCH + lw * 8 + sl; const size_t m = m0 + t, mp = t > 0 ? m - 1 : m;
                const bf16_t* pc = p.pr + m * DSH + ch0; const bf16_t* pp = p.pr + mp * DSH + ch0;
                L.r0 = *(const u32x4*)pc; L.k0 = *(const u32x4*)(pc + 1024); L.v0 = *(const u32x4*)(pc + 2048);
                L.r1 = *(const u32x4*)pp; L.k1 = *(const u32x4*)(pp + 1024); L.v1 = *(const u32x4*)(pp + 2048);
                L.a = *(const u32x4*)(p.abuf + m * 1024 + ch0); L.e = *(const u32x4*)(p.ebuf + m * 1024 + ch0);
            };
            auto process = [&](int c, const LRaw& L) {
                const int sidx = lw * 8 + sl, t = c * SCH + sidx; const size_t m = m0 + t;
                f32x4 r0, r1, k0, k1, v0, v1, pr0, pr1, pk0, pk1, pv0, pv1, a0, a1, e0, e1;
                unpack8(L.r0, r0, r1); unpack8(L.k0, k0, k1); unpack8(L.v0, v0, v1); unpack8(L.r1, pr0, pr1); unpack8(L.k1, pk0, pk1); unpack8(L.v1, pv0, pv1);
                unpack8(L.a, a0, a1); unpack8(L.e, e0, e1);
                if (c == 0 && lw == 0) {
                    f32x4 q[6];
#pragma unroll
                    for (int i = 0; i < 6; ++i) q[i] = (f32x4){0.f, 0.f, 0.f, 0.f};
                    if (!prompt) { const float* sp = p.in[I_SSHIFT] + (size_t)b * DSH + ch0;
                        q[0] = *(const f32x4*)sp; q[1] = *(const f32x4*)(sp + 4); q[2] = *(const f32x4*)(sp + 1024); q[3] = *(const f32x4*)(sp + 1028); q[4] = *(const f32x4*)(sp + 2048); q[5] = *(const f32x4*)(sp + 2052); }
                    if (sl == 0) { pr0 = q[0]; pr1 = q[1]; pk0 = q[2]; pk1 = q[3]; pv0 = q[4]; pv1 = q[5]; }
                }
                r0 = r0 + (pr0 - r0) * mur0; r1 = r1 + (pr1 - r1) * mur1; k0 = k0 + (pk0 - k0) * muk0; k1 = k1 + (pk1 - k1) * muk1; v0 = v0 + (pv0 - v0) * muv0; v1 = v1 + (pv1 - v1) * muv1;
                f32x4 w0, w1;
#pragma unroll
                for (int i = 0; i < 4; ++i) { w0[i] = __expf(-e0[i]); w1[i] = __expf(-e1[i]); }
                f32x4 kk0 = k0 * kkc0, kk1 = k1 * kkc1;
                const float n2 = reduce8(dot4(kk0, kk0) + dot4(kk1, kk1)), inv = 1.f / fmaxf(sqrtf(n2), 1e-12f);
                kk0 = kk0 * inv; kk1 = kk1 * inv;
                const f32x4 k20 = k0 * (1.f + (a0 - 1.f) * kac0), k21 = k1 * (1.f + (a1 - 1.f) * kac1), bb0 = kk0 * a0, bb1 = kk1 * a1;
                const float rks = reduce8(dot4(r0 * k20, rkc0) + dot4(r1 * k21, rkc1));
                if (g == 0 && hf == 0 && t < T) p.rk[m * 16 + h] = rks;
                LAS float* so = (LAS float*)(lds + (c & 1) * SBUF + sidx * 1536) + 8 * g;
                *(LAS f32x4*)(so) = r0; *(LAS f32x4*)(so + 4) = r1; *(LAS f32x4*)(so + 64) = w0; *(LAS f32x4*)(so + 68) = w1;
                *(LAS f32x4*)(so + 128) = k20; *(LAS f32x4*)(so + 132) = k21; *(LAS f32x4*)(so + 192) = -kk0; *(LAS f32x4*)(so + 196) = -kk1;
                *(LAS f32x4*)(so + 256) = bb0; *(LAS f32x4*)(so + 260) = bb1; *(LAS f32x4*)(so + 320) = v0; *(LAS f32x4*)(so + 324) = v1;
            };
            const int L = lw * 64 + lane;
            auto reduce_y = [&](int buf, int t0) {
                const LAS float* yb = (const LAS float*)(lds + YP_OFF + buf * YP_BYTES);
#pragma unroll
                for (int i = 0; i < 2; ++i) { const int idx = i * 256 + L, step = idx >> 5, r = idx & 31;
                    const f32x4 a = *(const LAS f32x4*)(yb + idx * 8), bq = *(const LAS f32x4*)(yb + idx * 8 + 4);
                    const float y = ((a[0] + a[1]) + (a[2] + a[3])) + ((bq[0] + bq[1]) + (bq[2] + bq[3]));
                    p.ybuf[(m0 + t0 + step) * 1024 + h * 64 + hf * 32 + r] = f2bf(y); }
            };
            load_chunk(0, cur);
            if (nch > 1) load_chunk(1, nxt);
            process(0, cur);
            __syncthreads();
            for (int c = 0; c < nch; ++c) {
                const int nst = (T - c * SCH) < SCH ? (T - c * SCH) : SCH;
                if (c + 1 < nch) {
                    cur = nxt;
                    if (c + 2 < nch) load_chunk(c + 2, nxt);
                    process(c + 1, cur);
                }
                if (c > 0) reduce_y(1, (c - 1) * SCH + 16);
                __syncthreads();
                if (nst > 16) { reduce_y(0, c * SCH); __syncthreads(); }
            }
            { const int lastn = T - (nch - 1) * SCH; if (lastn > 16) reduce_y(1, (nch - 1) * SCH + 16); else reduce_y(0, (nch - 1) * SCH); }
            __syncthreads();
        } else {
            __builtin_amdgcn_s_setprio(3);
            const int j = lane & 7, row = hf * 32 + wid * 8 + (lane >> 3);
            f32x2 S[4];
#pragma unroll
            for (int i = 0; i < 4; ++i) S[i] = (f32x2){0.f, 0.f};
            if (!prompt) { const float* sp = p.in[I_SWKV] + ((size_t)chain * 64 + row) * 64; const f32x4 a = *(const f32x4*)(sp + 4 * j), bq = *(const f32x4*)(sp + 32 + 4 * j);
                S[0] = a.lo; S[1] = a.hi; S[2] = bq.lo; S[3] = bq.hi; }
            __syncthreads();
            for (int c = 0; c < nch; ++c) {
                const LAS float* base = (const LAS float*)(lds + (c & 1) * SBUF) + 4 * j;
                const LAS float* vb = (const LAS float*)(lds + (c & 1) * SBUF) + 320 + row;
                const int nst = (T - c * SCH) < SCH ? (T - c * SCH) : SCH;
                ScanOps cur, nxt;
                scan_ld(cur, base, vb);
                for (int g16 = 0; g16 < nst; g16 += 16) {
                    unsigned ywb = (unsigned)(YP_OFF + (g16 >> 4) * YP_BYTES + (wid * 64 + lane) * 4);
                    asm volatile("" : "+v"(ywb));
                    LAS float* yw = (LAS float*)(lds + ywb);
#pragma unroll
                    for (int s16 = 0; s16 < 16; ++s16) {
                        scan_ld(nxt, base + (g16 + s16 + 1) * 384, vb + (g16 + s16 + 1) * 384);
                        f32x2 d = S[0] * cur.n0.lo; d = S[1] * cur.n0.hi + d; d = S[2] * cur.n1.lo + d; d = S[3] * cur.n1.hi + d;
                        const float sa = reduce8(d.x + d.y);
                        const f32x2 sa2 = (f32x2){sa, sa}, v2 = (f32x2){cur.v, cur.v};
                        S[0] = S[0] * cur.w0.lo + (cur.b0.lo * sa2 + cur.k0.lo * v2);
                        S[1] = S[1] * cur.w0.hi + (cur.b0.hi * sa2 + cur.k0.hi * v2);
                        S[2] = S[2] * cur.w1.lo + (cur.b1.lo * sa2 + cur.k1.lo * v2);
                        S[3] = S[3] * cur.w1.hi + (cur.b1.hi * sa2 + cur.k1.hi * v2);
                        f32x2 e = S[0] * cur.r0.lo; e = S[1] * cur.r0.hi + e; e = S[2] * cur.r1.lo + e; e = S[3] * cur.r1.hi + e;
                        yw[s16 * 256] = e.x + e.y;
                        cur = nxt;
                    }
                    __syncthreads();
                }
            }
            float* so = p.out + (prompt ? O_WP : O_WS) + ((size_t)chain * 64 + row) * 64;
            *(f32x4*)(so + 4 * j) = (f32x4){S[0].x, S[0].y, S[1].x, S[1].y}; *(f32x4*)(so + 32 + 4 * j) = (f32x4){S[2].x, S[2].y, S[3].x, S[3].y};
            __builtin_amdgcn_s_setprio(0);
            __syncthreads();
        }
    }
}

__device__ __forceinline__ void phase_yn(CParams& p, LAS unsigned char* lds) {
    const int tid = tid_opaque(), wid = tid >> 6, lane = tid & 63;
    const int gw = blockIdx.x * 8 + wid, nw = gridDim.x * 8;
    {
        const int half = gw & 1, c0 = half * 512 + lane * 8, h = c0 >> 6;
        const f32x4 mu0 = *(const f32x4*)(p.in[I_MU] + 2048 + c0), mu1 = *(const f32x4*)(p.in[I_MU] + 2048 + c0 + 4);
        const f32x4 lg0 = *(const f32x4*)(p.in[I_LXG] + c0), lg1 = *(const f32x4*)(p.in[I_LXG] + c0 + 4);
        const f32x4 lb0 = *(const f32x4*)(p.in[I_LXB] + c0), lb1 = *(const f32x4*)(p.in[I_LXB] + c0 + 4);
        for (int it0 = gw; it0 < M * 2; it0 += 2 * nw) {
            u32x4 yr[2], vc[2], vp[2]; f32x4 q0[2], q1[2]; float rkv[2]; bool val[2], usef[2];
#pragma unroll
            for (int b = 0; b < 2; ++b) {
                const int it = it0 + b * nw; val[b] = it < M * 2; const int m = val[b] ? (it >> 1) : 0;
                const bool prompt = m < MP; const int t = prompt ? (m & 4095) : ((m - MP) & 15); const int sq = prompt ? 0 : ((m - MP) >> 4);
                yr[b] = *(const u32x4*)(p.ybuf + (size_t)m * 1024 + c0);
                vc[b] = NTL(u32x4, p.pr + (size_t)m * DSH + 2048 + c0);
                vp[b] = NTL(u32x4, p.pr + (size_t)(t > 0 ? m - 1 : m) * DSH + 2048 + c0);
                usef[b] = (t == 0);
                q0[b] = (f32x4){0.f, 0.f, 0.f, 0.f}; q1[b] = q0[b];
                if (t == 0 && !prompt) { const float* sp = p.in[I_SSHIFT] + (size_t)sq * DSH + 2048 + c0; q0[b] = *(const f32x4*)sp; q1[b] = *(const f32x4*)(sp + 4); }
                rkv[b] = p.rk[(size_t)m * 16 + h];
            }
#pragma unroll
            for (int b = 0; b < 2; ++b) {
                const int it = it0 + b * nw; const int m = it >> 1;
                f32x4 y0, y1, v0, v1, w0, w1; unpack8(yr[b], y0, y1); unpack8(vc[b], v0, v1); unpack8(vp[b], w0, w1);
                if (usef[b]) { w0 = q0[b]; w1 = q1[b]; }
                const float mean = reduce8((y0[0] + y0[1]) + (y0[2] + y0[3]) + (y1[0] + y1[1]) + (y1[2] + y1[3])) * (1.f / 64.f);
                y0 -= mean; y1 -= mean;
                const float rstd = rsqrtf(reduce8(dot4(y0, y0) + dot4(y1, y1)) * (1.f / 64.f) + 64e-5f);
                v0 = v0 + (w0 - v0) * mu0; v1 = v1 + (w1 - v1) * mu1;
                y0 = y0 * rstd * lg0 + lb0 + v0 * rkv[b]; y1 = y1 * rstd * lg1 + lb1 + v1 * rkv[b];
                if (val[b]) *(u32x4*)(p.ybuf + (size_t)m * 1024 + c0) = pack8(y0, y1);
            }
        }
    }
    LAS float* tile = (LAS float*)lds;
    convT(tile, p.in[I_WOC], nullptr, 1024, 512, 1024, p.WocT, 512, nullptr, 0);
    convT(tile, p.in[I_WOR], nullptr, 1024, 1024, 1024, p.WorT, 1024, nullptr, 0);
    convT(tile, p.in[I_WOUT], nullptr, 1024, 1024, 1024, p.WoutT, 1024, nullptr, 0);
    convT(tile, p.in[I_WQ], nullptr, 1024, 1024, 1024, p.WqT, 1024, p.in[I_GX], 0);
    convT(tile, p.in[I_WOX], nullptr, 1024, 1024, 1024, p.WoxT, 1024, nullptr, 0);
    convT(tile, p.in[I_WFG], p.in[I_WFU], 2816, 1024, 5632, p.WguT, 1024, p.in[I_GFFN], 2);
    convT(tile, p.in[I_WFD], nullptr, 1024, 2816, 1024, p.WdT, 2816, nullptr, 0);
}

__device__ __forceinline__ void phase_final(CParams& p) {
    const int tid = tid_opaque(), wid = tid >> 6, lane = tid & 63;
    const int gw = blockIdx.x * 8 + wid, nw = gridDim.x * 8;
    f32x4 gfin[4];
#pragma unroll
    for (int i = 0; i < 4; ++i) gfin[i] = *(const f32x4*)(p.in[I_GFIN] + lane * 4 + i * 256);
    for (int row0 = gw; row0 < M; row0 += 2 * nw) {
        f32x4 v[2][4]; float sv[2];
#pragma unroll
        for (int b = 0; b < 2; ++b) { const int rr = row0 + b * nw, row = rr < M ? rr : row0;
#pragma unroll
            for (int i = 0; i < 4; ++i) v[b][i] = __builtin_nontemporal_load((const f32x4*)(p.out + (size_t)row * 1024 + lane * 4 + i * 256)); }
#pragma unroll
        for (int b = 0; b < 2; ++b) { float q = 0.f;
#pragma unroll
            for (int i = 0; i < 4; ++i) q += dot4(v[b][i], v[b][i]);
            sv[b] = wave_sum(q); }
#pragma unroll
        for (int b = 0; b < 2; ++b) { const int row = row0 + b * nw;
            if (row < M) { const float rs = rsqrtf(sv[b] * (1.f / 1024.f) + 1e-6f);
#pragma unroll
                for (int i = 0; i < 4; ++i) __builtin_nontemporal_store(v[b][i] * rs * gfin[i], (f32x4*)(p.out + (size_t)row * 1024 + lane * 4 + i * 256)); } }
    }
}


enum { NK_EA = 0, NK_G, NK_CONV, NK_RWKV, NK_OUT, NK_Q, NK_OX, NK_FFN1, NK_DOWN };
__device__ __forceinline__ u32x2 pack4(f32x4 v) { u32x2 w; w.x = pk2(v[0], v[1]); w.y = pk2(v[2], v[3]); return w; }
__device__ __forceinline__ f32x4 unpack4w(u32x2 w) { return (f32x4){bf_lo(w.x), bf_hi(w.x), bf_lo(w.y), bf_hi(w.y)}; }
__device__ __forceinline__ void narrow_job(CParams& p, LAS unsigned char* lds, const int nk, const bf16_t* A, const int lda, const int K, const bf16_t* B, const int ldb, const int nstrips) {
    const int tid = tid_opaque(), wid = __builtin_amdgcn_readfirstlane(tid >> 6), lane = tid & 63, fr = lane & 15, fq = lane >> 4, kh = wid >> 2, wq = wid & 3;
    LAS f32x4* red = (LAS f32x4*)lds;
    const int KH = K / 2, nks = KH / 32;
    for (int uidx = blockIdx.x; uidx < nstrips * 4; uidx += gridDim.x) {
        const int strip = uidx >> 2, rq = uidx & 3, c0 = strip * 16;
        const bf16_t* b0p; const bf16_t* b1p;
        if (nk == NK_FFN1) { const int pn = c0 >> 7, w = c0 & 127; b0p = B + (size_t)(pn * 256 + w + fr) * ldb + 8 * fq + kh * KH; b1p = b0p + (size_t)128 * ldb; }
        else { b0p = B + (size_t)(c0 + fr) * ldb + 8 * fq + kh * KH; b1p = b0p; }
        const size_t row = (size_t)MP + rq * 64 + wq * 16 + fr;
        const bf16_t* ap = A + row * lda + 8 * fq + kh * KH;
        f32x4 acc0 = (f32x4){0.f, 0.f, 0.f, 0.f}, acc1 = acc0;
        for (int kb = 0; kb < nks; kb += 8) {
            {
                bf16x8 av[8], bv[8], cv[8];
#pragma unroll
                for (int i = 0; i < 8; ++i) if (kb + i < nks) { av[i] = *(const bf16x8*)(ap + (kb + i) * 32); bv[i] = *(const bf16x8*)(b0p + (kb + i) * 32); if (nk == NK_FFN1) cv[i] = *(const bf16x8*)(b1p + (kb + i) * 32); }
#pragma unroll
                for (int i = 0; i < 8; ++i) if (kb + i < nks) { acc0 = __builtin_amdgcn_mfma_f32_16x16x32_bf16(bv[i], av[i], acc0, 0, 0, 0);
                    if (nk == NK_FFN1) acc1 = __builtin_amdgcn_mfma_f32_16x16x32_bf16(cv[i], av[i], acc1, 0, 0, 0); }
            }
        }
        if (kh == 1) { red[(wq * 64 + lane) * 2] = acc0; if (nk == NK_FFN1) red[(wq * 64 + lane) * 2 + 1] = acc1; }
        __syncthreads();
        if (kh == 0) {
            const f32x4 v = acc0 + red[(wq * 64 + lane) * 2]; const int c = c0 + 4 * fq;
            switch (nk) {
            case NK_EA: {
                if (c < 1024) { const f32x4 bias = *(const f32x4*)(p.in[I_W0] + c); *(u32x2*)(p.ebuf + row * 1024 + c) = pack4(sigm4(v + bias) * 0.60653066f); }
                else { const f32x4 bias = *(const f32x4*)(p.in[I_A0] + (c - 1024)); *(u32x2*)(p.abuf + row * 1024 + (c - 1024)) = pack4(sigm4(v + bias)); }
            } break;
            case NK_G: { bf16_t* yp = p.ybuf + row * 1024 + c; const f32x4 y = unpack4w(*(const u32x2*)yp); *(u32x2*)yp = pack4(y * v); } break;
            case NK_CONV: { const f32x4 g1 = unpack4w(*(const u32x2*)(p.gates + row * 2048 + c)); *(u32x2*)(p.tmp + row * 1024 + c) = pack4(g1 * v); } break;
            case NK_RWKV: { const f32x4 g2 = unpack4w(*(const u32x2*)(p.gates + row * 2048 + 1024 + c)), tq = unpack4w(*(const u32x2*)(p.tmp + row * 1024 + c));
                *(u32x2*)(p.merged + row * 1024 + c) = pack4(tq + g2 * v); } break;
            case NK_OUT: case NK_OX: {
                const float* rp = (nk == NK_OUT) ? p.in[I_XS] + (row - MP) * 1024 + c : p.out + row * 1024 + c;
                const f32x4 h = *(const f32x4*)rp + v;
                *(f32x4*)(p.out + row * 1024 + c) = h; *(u32x2*)(p.hb + row * 1024 + c) = pack4(h);
                float sq = dot4(h, h); sq += __shfl_xor(sq, 16); sq += __shfl_xor(sq, 32);
                if (fq == 0) unsafeAtomicAdd((nk == NK_OUT ? p.ss1 : p.ss2) + row, sq);
            } break;
            case NK_DOWN: { float* hp = p.out + row * 1024 + c; *(f32x4*)hp = *(const f32x4*)hp + v; } break;
            case NK_Q: { const float rs = rsqrtf(p.ss1[row] * (1.f / 1024.f) + 1e-6f); *(u32x2*)(p.q + row * 1024 + c) = pack4(v * rs); } break;
            case NK_FFN1: { const float rs = rsqrtf(p.ss2[row] * (1.f / 1024.f) + 1e-6f); const f32x4 g = v * rs, uu = (acc1 + red[(wq * 64 + lane) * 2 + 1]) * rs;
                *(u32x2*)(p.hid + row * DFF + c) = pack4(g * sigm4(g) * uu); } break;
            default: break;
            }
        }
        __syncthreads();
    }
}

__device__ __forceinline__ void narrow_attn(CParams& p) {
    const int tid = tid_opaque(), wid = __builtin_amdgcn_readfirstlane(tid >> 6), lane = tid & 63, fr = lane & 15, fq = lane >> 4;
    for (int pair = blockIdx.x; pair < 64; pair += gridDim.x) {
        const int sq = pair >> 2, h = pair & 3; const size_t row = (size_t)MP + sq * 16 + fr;
        {
            const bf16_t* ap = p.q + row * 1024 + h * 256 + 8 * fq;
            bf16x8 av[8], bv[2][8];
#pragma unroll
            for (int k = 0; k < 8; ++k) av[k] = *(const bf16x8*)(ap + k * 32);
#pragma unroll
            for (int u = 0; u < 2; ++u) { const bf16_t* bp = p.Kb + ((size_t)(8 + sq) * 256 + (wid * 2 + u) * 16 + fr) * 1024 + h * 256 + 8 * fq;
#pragma unroll
                for (int k = 0; k < 8; ++k) bv[u][k] = *(const bf16x8*)(bp + k * 32); }
#pragma unroll
            for (int u = 0; u < 2; ++u) {
                f32x4 acc = (f32x4){0.f, 0.f, 0.f, 0.f};
#pragma unroll
                for (int k = 0; k < 8; ++k) acc = __builtin_amdgcn_mfma_f32_16x16x32_bf16(bv[u][k], av[k], acc, 0, 0, 0);
                f32x4 e;
#pragma unroll
                for (int j = 0; j < 4; ++j) e[j] = __expf(acc[j] * 0.0625f);
                const u32x2 w = pack4(e); const f32x4 r = unpack4w(w);
                *(u32x2*)(p.P + row * 1024 + h * 256 + (wid * 2 + u) * 16 + 4 * fq) = w;
                float sm = (r[0] + r[1]) + (r[2] + r[3]); sm += __shfl_xor(sm, 16); sm += __shfl_xor(sm, 32);
                if (fq == 0) unsafeAtomicAdd(p.psum + row * 4 + h, sm);
            }
        }
        asm volatile("s_waitcnt vmcnt(0)" ::: "memory");
        __syncthreads();
        {
            const bf16_t* ap = p.P + row * 1024 + h * 256 + 8 * fq;
            bf16x8 av[8], bv[2][8];
#pragma unroll
            for (int k = 0; k < 8; ++k) av[k] = *(const bf16x8*)(ap + k * 32);
#pragma unroll
            for (int u = 0; u < 2; ++u) { const bf16_t* bp = p.VT + ((size_t)h * 256 + (wid * 2 + u) * 16 + fr) * VTLD + (size_t)(8 + sq) * 256 + 8 * fq;
#pragma unroll
                for (int k = 0; k < 8; ++k) bv[u][k] = *(const bf16x8*)(bp + k * 32); }
            const float inv = 1.f / __hip_atomic_load(p.psum + row * 4 + h, __ATOMIC_RELAXED, __HIP_MEMORY_SCOPE_AGENT);
#pragma unroll
            for (int u = 0; u < 2; ++u) {
                f32x4 acc = (f32x4){0.f, 0.f, 0.f, 0.f};
#pragma unroll
                for (int k = 0; k < 8; ++k) acc = __builtin_amdgcn_mfma_f32_16x16x32_bf16(bv[u][k], av[k], acc, 0, 0, 0);
                *(u32x2*)(p.ob + row * 1024 + h * 256 + (wid * 2 + u) * 16 + 4 * fq) = pack4(acc * inv);
            }
        }
    }
}

__device__ __forceinline__ void narrow_phase(CParams& p, LAS unsigned char* lds, const int ph) {
    switch (ph) {
    case 3: narrow_job(p, lds, NK_EA, p.lin, 256, 128, p.Wea, 128, 128); break;
    case 6: narrow_job(p, lds, NK_G, p.lin + 128, 256, 128, p.Wg, 128, 64); break;
    case 7: narrow_job(p, lds, NK_CONV, p.sconv, 512, 512, p.WocT, 512, 64); narrow_job(p, lds, NK_RWKV, p.ybuf, 1024, 1024, p.WorT, 1024, 64); break;
    case 8: narrow_job(p, lds, NK_OUT, p.merged, 1024, 1024, p.WoutT, 1024, 64); break;
    case 9: narrow_job(p, lds, NK_Q, p.hb, 1024, 1024, p.WqT, 1024, 64); break;
    case 12: narrow_job(p, lds, NK_OX, p.ob, 1024, 1024, p.WoxT, 1024, 64); break;
    case 13: narrow_job(p, lds, NK_FFN1, p.hb, 1024, 1024, p.WguT, 1024, 176); break;
    case 14: narrow_job(p, lds, NK_DOWN, p.hid, DFF, DFF, p.WdT, DFF, 64); break;
    default: break;
    }
}

__device__ __forceinline__ bool get_job(CParams& p, int ph, int j, Job& jb) {
    jb.mode = 0; jb.lda = 1024; jb.ldb = 1024; jb.K = 1024; jb.Mrows = M; jb.N = 1024; jb.A2 = nullptr; jb.B2 = nullptr;
    const void* A = nullptr; const void* B = nullptr; bool ok = (j == 0);
    switch (ph) {
    case 1: A = p.xn; B = p.WinT; jb.N = 6400; jb.kind = E_G1; jb.mode = 3; jb.A2 = (const char*)p.memn; jb.B2 = (const char*)p.WkvT; break;
    case 3: A = p.lin; B = p.Wea; jb.lda = 256; jb.ldb = 128; jb.K = 128; jb.N = 2048; jb.kind = E_EA; jb.Mrows = MP; break;
    case 6: A = p.lin + 128; B = p.Wg; jb.lda = 256; jb.ldb = 128; jb.K = 128; jb.kind = E_G; jb.Mrows = MP; break;
    case 7:
        ok = j < 2; jb.Mrows = MP;
        if (j == 0) { A = p.sconv; B = p.WocT; jb.lda = 512; jb.ldb = 512; jb.K = 512; jb.kind = E_CONV; }
        else { A = p.ybuf; B = p.WorT; jb.kind = E_RWKV; }
        break;
    case 8: A = p.merged; B = p.WoutT; jb.kind = E_OUT; jb.Mrows = MP; break;
    case 9: A = p.hb; B = p.WqT; jb.kind = E_Q; jb.Mrows = MP; break;
    case 10:
        ok = j < 2;
        if (j == 0) { A = p.q; B = p.Kb; jb.K = 256; jb.mode = 1; jb.kind = E_S; }
        else { A = p.P; B = p.VT; jb.K = 256; jb.ldb = VTLD; jb.mode = 2; jb.kind = E_PV; }
        break;
    case 12: A = p.ob; B = p.WoxT; jb.kind = E_OX; jb.Mrows = MP; break;
    case 13: A = p.hb; B = p.WguT; jb.N = 5632; jb.kind = E_FFN1; jb.Mrows = MP; break;
    case 14:
        A = p.hid; B = p.WdT; jb.lda = DFF; jb.ldb = DFF; jb.K = DFF; jb.Mrows = MP; jb.kind = E_DOWN; break;
    default: ok = false; break;
    }
    jb.A = (const char*)A; jb.B = (const char*)B;
    return ok;
}

__global__ void __launch_bounds__(512, 2) mega(Params p_unused) {
    CParams& p = *(CParams*)__builtin_amdgcn_kernarg_segment_ptr();
    extern __shared__ __attribute__((aligned(16))) unsigned char shm[];
    LAS unsigned char* lds = (LAS unsigned char*)shm;
    cg::grid_group grid = cg::this_grid();
    volatile LAS unsigned* st = (volatile LAS unsigned*)(lds + LDS_ST);
    if (threadIdx.x < 2) st[threadIdx.x] = 0u;
    XcdBarrier xb; xb.bar = p.bar; xb.x = 0; xb.st = st;
    for (int ph = p.ph_lo; ph < p.ph_hi; ++ph) {
#ifdef PROBE_PH
        for (int rep = 0; rep < (ph == PROBE_PH ? 2 : 1); ++rep) {
#endif
        switch (ph) {
        case 0: phase_prep(p, lds); break;
        case 2: phase_conv(p, lds); break;
        case 4: phase_scan(p, lds); break;
        case 5: phase_yn(p, lds); break;
        case 15: phase_final(p); break;
        default: break;
        }
        for (int j = 0; j < 3; ++j) { Job jb; if (!get_job(p, ph, j, jb)) break; gemm_phase(lds, p, jb); }
        narrow_phase(p, lds, ph);
        if (ph == 10) narrow_attn(p);
#ifdef PROBE_PH
        }
#endif
        if (ph + 1 < p.ph_hi) {
            if (ph == 0) {
                grid.sync();
                xb = xcd_barrier_post(p.bar, st);
            } else if (ph != 10) xcd_barrier(xb);
        }
    }
}

extern "C" void kernel_launch(void* const* d_in, const int* in_sizes, int n_in, void* d_out, int out_size, void* d_ws, size_t ws_size, hipStream_t stream) {
    static int grid_blocks = 0;
    if (!grid_blocks) {
        int dev = 0, cus = 0, per_cu = 0;
        hipGetDevice(&dev);
        hipDeviceGetAttribute(&cus, hipDeviceAttributeMultiprocessorCount, dev);
        hipFuncSetAttribute((const void*)mega, hipFuncAttributeMaxDynamicSharedMemorySize, LDS_BYTES);
        hipOccupancyMaxActiveBlocksPerMultiprocessor(&per_cu, (const void*)mega, 512, LDS_BYTES);
        if (per_cu < 1) { fprintf(stderr, "occupancy query returned %d\n", per_cu); per_cu = 1; }
        grid_blocks = cus * per_cu;
    }
    Params p{};
    for (int i = 0; i < N_IN; ++i) p.in[i] = (const float*)d_in[i];
    p.out = (float*)d_out;
    unsigned char* w = (unsigned char*)d_ws; size_t off = 0;
    auto take = [&](size_t bytes) { unsigned char* r = w + off; off += (bytes + 255) & ~(size_t)255; return r; };
    p.WinT = (bf16_t*)take((size_t)6400 * 1024 * 2); p.WkvT = (bf16_t*)take((size_t)2048 * 1024 * 2);
    p.Wea = (bf16_t*)take((size_t)2048 * 256 * 2); p.Wg = (bf16_t*)take((size_t)1024 * 256 * 2);
    p.Kb = (bf16_t*)take((size_t)24 * 256 * 1024 * 2); p.VT = (bf16_t*)take((size_t)1024 * VTLD * 2);
    p.ss1 = (float*)take((size_t)M * 4); p.ss2 = (float*)take((size_t)M * 4); p.ss3 = (float*)take((size_t)M * 4);
    p.psum = (float*)take((size_t)M * 16); p.rk = (float*)take((size_t)M * 64);
    p.bar = (unsigned*)take((size_t)XCD_BAR_WORDS * 4);
    unsigned char* RA = take((size_t)MPAD * 1024 * 2); p.xn = (bf16_t*)RA; p.ebuf = (bf16_t*)RA; p.hb = (bf16_t*)RA;
    unsigned char* RB = take((size_t)M * DSH * 2); p.pr = (bf16_t*)RB; p.hid = (bf16_t*)RB;
    p.tmp = (bf16_t*)RB; p.q = (bf16_t*)RB; p.merged = (bf16_t*)(RB + (size_t)MPAD * 1024 * 2); p.ob = p.merged; p.P = (bf16_t*)(RB + (size_t)2 * MPAD * 1024 * 2);
    p.lin = (bf16_t*)take((size_t)M * 256 * 2);
    unsigned char* RD = take((size_t)MPAD * 1024 * 2); p.u = (bf16_t*)RD; p.ybuf = (bf16_t*)RD;
    unsigned char* RE = take((size_t)M * 1024 * 2); p.memn = (bf16_t*)RE; p.abuf = (bf16_t*)RE;
    { size_t o = 0; auto sub = [&](size_t bytes) { unsigned char* r = RE + o; o += (bytes + 255) & ~(size_t)255; return (bf16_t*)r; };
      p.WocT = sub((size_t)1024 * 512 * 2); p.WorT = sub((size_t)1024 * 1024 * 2); p.WoutT = sub((size_t)1024 * 1024 * 2); p.WqT = sub((size_t)1024 * 1024 * 2);
      p.WoxT = sub((size_t)1024 * 1024 * 2); p.WguT = sub((size_t)5632 * 1024 * 2); p.WdT = sub((size_t)1024 * DFF * 2); }
    p.sconv = (bf16_t*)take((size_t)M * 512 * 2);
    p.gates = (bf16_t*)d_out;
    if (off > ws_size) { fprintf(stderr, "workspace too small: need %zu have %zu\n", off, ws_size); return; }
    p.ph_lo = 0; p.ph_hi = NPHASE;
    void* args[] = {&p};
    hipError_t e = hipLaunchCooperativeKernel((const void*)mega, dim3(grid_blocks), dim3(512), args, LDS_BYTES, stream);
    if (e != hipSuccess) fprintf(stderr, "cooperative launch failed: %s (grid %d)\n", hipGetErrorString(e), grid_blocks);
}
```

```cpp
#include <hip/hip_runtime.h>
#include <hip/hip_cooperative_groups.h>
#include <cstdio>
namespace cg = cooperative_groups;

#define LAS __attribute__((address_space(3)))
typedef unsigned short bf16_t;
typedef short bf16x8 __attribute__((ext_vector_type(8)));
typedef float f32x4 __attribute__((ext_vector_type(4)));
typedef unsigned u32x4 __attribute__((ext_vector_type(4)));
typedef unsigned u32x2 __attribute__((ext_vector_type(2)));
typedef float f32x2 __attribute__((ext_vector_type(2)));

constexpr int D = 1024, MP = 32768, MS = 256, M = MP + MS, MPAD = M + 256;
constexpr int DSH = 3328, DCV = 512, DFF = 2816;
constexpr int VTLD = 24 * 256;
constexpr int LDS_ST = 132608, LDS_BYTES = LDS_ST + 64;
constexpr int NPHASE = 16;

constexpr size_t O_MK = (size_t)M * D, O_MV = O_MK + 2048 * 1024, O_CP = O_MV + 2048 * 1024, O_SP = O_CP + 8 * 30 * 512,
                 O_WP = O_SP + 8 * 3328, O_CS = O_WP + 8 * 16 * 4096, O_SS = O_CS + 16 * 30 * 512, O_WS = O_SS + 16 * 3328;

enum { I_XP = 0, I_XS, I_CK, I_CV, I_SCONV, I_SSHIFT, I_SWKV, I_MEM, I_GMIX, I_WIN, I_MU, I_WDW, I_BDW, I_LCG, I_LCB, I_WOC, I_W0, I_WUP, I_A0, I_AUP,
       I_GUP, I_KK, I_KA, I_RK, I_LXG, I_LXB, I_WOR, I_WOUT, I_GX, I_GMEM, I_WQ, I_WK, I_WV, I_WOX, I_GFFN, I_WFG, I_WFU, I_WFD, I_GFIN, N_IN };

struct Params {
    const float* in[N_IN];
    float* out;
    bf16_t *WinT, *WkvT, *Wea, *Wg, *WocT, *WorT, *WoutT, *WqT, *WoxT, *WguT, *WdT, *Kb, *VT;
    float *ss1, *ss2, *ss3, *psum, *rk;
    bf16_t *memn, *xn, *ebuf, *hb, *pr, *hid, *tmp, *q, *merged, *ob, *P, *lin, *u, *ybuf, *abuf, *sconv, *gates;
    unsigned* bar;
    int ph_lo, ph_hi;
};

typedef const __attribute__((address_space(4))) Params CParams;

__device__ __forceinline__ int tid_opaque() { int t = threadIdx.x; asm volatile("" : "+v"(t)); return t; }
__device__ __forceinline__ float bf2f(bf16_t b) { return __uint_as_float(((unsigned)b) << 16); }
__device__ __forceinline__ float bf_lo(unsigned w) { return __uint_as_float(w << 16); }
__device__ __forceinline__ float bf_hi(unsigned w) { return __uint_as_float(w & 0xffff0000u); }
__device__ __forceinline__ unsigned pk2(float lo, float hi) { unsigned r; asm("v_cvt_pk_bf16_f32 %0, %1, %2" : "=v"(r) : "v"(lo), "v"(hi)); return r; }
__device__ __forceinline__ bf16_t f2bf(float f) { return (bf16_t)(pk2(f, 0.f) & 0xffffu); }
__device__ __forceinline__ u32x4 pack8(f32x4 a, f32x4 b) { u32x4 w; w.x = pk2(a[0], a[1]); w.y = pk2(a[2], a[3]); w.z = pk2(b[0], b[1]); w.w = pk2(b[2], b[3]); return w; }
__device__ __forceinline__ void unpack8(u32x4 w, f32x4& a, f32x4& b) { a = (f32x4){bf_lo(w.x), bf_hi(w.x), bf_lo(w.y), bf_hi(w.y)}; b = (f32x4){bf_lo(w.z), bf_hi(w.z), bf_lo(w.w), bf_hi(w.w)}; }
#define NTL(T, ptr) __builtin_nontemporal_load((const T*)(ptr))
#define NTS(T, ptr, val) __builtin_nontemporal_store((val), (T*)(ptr))
__device__ __forceinline__ float sigm(float x) { return 1.f / (1.f + __expf(-x)); }
__device__ __forceinline__ f32x4 sigm4(f32x4 v) { return (f32x4){sigm(v[0]), sigm(v[1]), sigm(v[2]), sigm(v[3])}; }
__device__ __forceinline__ float dot4(f32x4 a, f32x4 b) { return a[0] * b[0] + a[1] * b[1] + a[2] * b[2] + a[3] * b[3]; }
template <int CTRL> __device__ __forceinline__ float dppf(float x) { return __builtin_bit_cast(float, __builtin_amdgcn_mov_dpp(__builtin_bit_cast(int, x), CTRL, 0xf, 0xf, true)); }
__device__ __forceinline__ float reduce8(float x) { x += dppf<0xB1>(x); x += dppf<0x4E>(x); x += dppf<0x141>(x); return x; }
__device__ __forceinline__ float wave_sum(float x) {
    x += dppf<0xB1>(x); x += dppf<0x4E>(x); x += dppf<0x141>(x); x += dppf<0x140>(x);
    x += __builtin_bit_cast(float, __builtin_amdgcn_update_dpp(0, __builtin_bit_cast(int, x), 0x142, 0xa, 0xf, false));
    x += __builtin_bit_cast(float, __builtin_amdgcn_update_dpp(0, __builtin_bit_cast(int, x), 0x143, 0xc, 0xf, false));
    return __builtin_bit_cast(float, __builtin_amdgcn_readlane(__builtin_bit_cast(int, x), 63));
}

#define XB_TMO      128
#define XB_XCNT(j)  (256  + 64 * (j))
#define XB_XSUB(j)  (1280 + 64 * (j))
#define XB_XGEN(j)  (2304 + 64 * (j))
#define XB_TOP      3328
#define XB_TOPGEN   3392
#define XCD_BAR_WORDS 3456
#define XB_SPIN_CAP (1u << 18)

__device__ __forceinline__ unsigned xb_ld(unsigned* p)              { return __hip_atomic_load(p, __ATOMIC_RELAXED, __HIP_MEMORY_SCOPE_AGENT); }
__device__ __forceinline__ unsigned xb_add(unsigned* p, unsigned v) { return __hip_atomic_fetch_add(p, v, __ATOMIC_RELAXED, __HIP_MEMORY_SCOPE_AGENT); }
__device__ __forceinline__ unsigned xb_xcc_id() { return (unsigned)__builtin_amdgcn_s_getreg((3 << 11) | 20) & 0xFu; }
#define XB_SPIN(cond, bar) do { unsigned _sp = 0; while (cond) { __builtin_amdgcn_s_sleep(1); \
    if ((++_sp & 255u) == 0u) { if (xb_ld(&(bar)[XB_TMO])) break; if (_sp > XB_SPIN_CAP) { atomicAdd(&(bar)[XB_TMO], 1u); break; } } } } while (0)

struct XcdBarrier {
    unsigned* bar; unsigned x;
    volatile LAS unsigned* st;
};

__device__ __forceinline__ XcdBarrier xcd_barrier_post(unsigned* bar, volatile LAS unsigned* st) {
    XcdBarrier b; b.bar = bar; b.x = xb_xcc_id(); b.st = st;
    if (threadIdx.x == 0) (void)xb_add(&bar[XB_XCNT(b.x)], 1u);
    return b;
}
__device__ __forceinline__ void xcd_barrier_complete(unsigned* bar, unsigned x, unsigned& nloc, unsigned& nx) {
    const unsigned G = gridDim.x * gridDim.y * gridDim.z;
    unsigned sum, cnt, mine, sp = 0u;
    for (;;) {
        sum = 0u; cnt = 0u; mine = 0u;
#pragma unroll
        for (unsigned j = 0; j < 16; ++j) { const unsigned c = xb_ld(&bar[XB_XCNT(j)]); sum += c; cnt += (c > 0u) ? 1u : 0u; mine = (j == x) ? c : mine; }
        if (sum == G) break;
        __builtin_amdgcn_s_sleep(1);
        if ((++sp & 255u) == 0u) { if (xb_ld(&bar[XB_TMO])) break; if (sp > XB_SPIN_CAP) { atomicAdd(&bar[XB_TMO], 1u); break; } }
    }
    nloc = mine > 0u ? mine : 1u; nx = cnt > 0u ? cnt : 1u;
}

__device__ __forceinline__ void xcd_barrier(const XcdBarrier& b) {
    asm volatile("s_waitcnt vmcnt(0)" ::: "memory");
    __syncthreads();
    if (threadIdx.x == 0) {
        unsigned* bar = b.bar;
        __builtin_amdgcn_s_waitcnt(0);
        unsigned nloc = b.st[0], nx = b.st[1];
        if (nloc == 0u) { xcd_barrier_complete(bar, b.x, nloc, nx); b.st[0] = nloc; b.st[1] = nx; }
        const unsigned old = xb_add(&bar[XB_XSUB(b.x)], 1u);
        const unsigned gen = old / nloc;
        if (old + 1u == (gen + 1u) * nloc) {
            __builtin_amdgcn_fence(__ATOMIC_RELEASE, "agent");
            asm volatile("s_waitcnt vmcnt(0)" ::: "memory");
            const unsigned og = xb_add(&bar[XB_TOP], 1u);
            const unsigned tg = og / nx;
            if (og + 1u == (tg + 1u) * nx) xb_add(&bar[XB_TOPGEN], 1u);
            else XB_SPIN(xb_ld(&bar[XB_TOPGEN]) == tg, bar);
            __builtin_amdgcn_fence(__ATOMIC_ACQUIRE, "agent");
            xb_add(&bar[XB_XGEN(b.x)], 1u);
            asm volatile("s_waitcnt vmcnt(0)" ::: "memory");
        } else {
            XB_SPIN(xb_ld(&bar[XB_XGEN(b.x)]) == gen, bar);
            __builtin_amdgcn_fence(__ATOMIC_ACQUIRE, "agent");
            asm volatile("s_waitcnt vmcnt(0)" ::: "memory");
        }
    }
    __syncthreads();
}

constexpr int BM = 256, BK = 64, HALF = 128, HTB = HALF * BK * 2, NXCD = 8, WGM = 8;
__device__ __forceinline__ int lds_byte(int r, int c) { const int st = (r >> 4) * 2 + (c >> 5), rr = r & 15, cc = c & 31, ob = rr * 64 + cc * 2; return st * 1024 + (ob ^ (((ob >> 9) & 1) << 5)); }
__device__ __forceinline__ void stage_rc(int b, int& R, int& C) { const int st = b / 1024, sb = b % 1024, swz = sb ^ (((sb >> 9) & 1) << 5); R = (st >> 1) * 16 + swz / 64; C = (st & 1) * 32 + (swz % 64) / 2; }
__device__ __forceinline__ int perm32(int rho) { const int n = rho >> 4, i = rho & 15; return 8 * (i >> 2) + 4 * n + (i & 3); }

enum { E_G1 = 0, E_KV, E_VT, E_EA, E_G, E_CONV, E_RWKV, E_OUT, E_Q, E_S, E_PV, E_OX, E_FFN1, E_DOWN, E_DOWN_HALF };
struct Unit { const char* A; const char* B; int row0; int pn; int aux; int kind; };
struct Job { const char* A; const char* B; const char* A2; const char* B2; int lda, ldb, K, Mrows, N, mode, kind; };

struct Sched {
    const char* A; const char* B; const char* A2; const char* B2; size_t tA, tB; int nM, nN, nwg, nstd, G, c, mode, kind;
    __device__ __forceinline__ void init(const Job& j) {
        A = j.A; B = j.B; tA = (size_t)256 * j.lda * 2; tB = (size_t)256 * j.ldb * 2; nM = j.Mrows / 256; nN = j.N / 256; mode = j.mode;
        A2 = j.A2; B2 = j.B2; kind = j.kind; nstd = nM * nN;
        nwg = (mode == 1 || mode == 2) ? 512 : (mode == 3 ? nstd + 96 : (mode == 4 ? 8 : nstd)); G = (int)gridDim.x; c = (int)blockIdx.x;
    }
    __device__ __forceinline__ bool next(int i, Unit& u) const {
        const long L = (long)i * G + c; if (L >= nwg) return false;
        u.kind = kind;
        if (mode == 4) {
            const int pn = (int)L & 3, kh = (int)L >> 2;
            u.A = A + ((size_t)MP * DFF + (size_t)kh * (DFF / 2)) * 2; u.B = B + ((size_t)pn * 256 * DFF + (size_t)kh * (DFF / 2)) * 2; u.row0 = MP; u.pn = pn; u.aux = 256;
        } else if (mode == 3 && L >= nstd) {
            const int idx = (int)L - nstd;
            if (idx < 64) { const int pm = idx >> 3, pn = idx & 7; u.A = A2 + (size_t)pm * tA; u.B = B2 + (size_t)pn * tB; u.row0 = pm * 256; u.pn = pn; u.aux = 256; u.kind = E_KV; }
            else { const int i2 = idx - 64, pm = i2 >> 3, pn = i2 & 7; u.A = B2 + (size_t)(4 + pm) * tB; u.B = A2 + (size_t)pn * tA; u.row0 = pm * 256; u.pn = pn; u.aux = 256; u.kind = E_VT; }
        } else if (mode == 0 || mode == 3) {
            const int nwg = nstd;
            int wgid = (int)L; { const int q = nwg / NXCD, r = nwg % NXCD, xcd = wgid % NXCD, off = wgid / NXCD; wgid = (xcd < r ? xcd * (q + 1) : r * (q + 1) + (xcd - r) * q) + off; }
            const int nig = WGM * nN, gid = wgid / nig, fm = gid * WGM, gsz = (nM - fm) < WGM ? (nM - fm) : WGM;
            const int pm = fm + ((wgid % nig) % gsz), pn = (wgid % nig) / gsz;
            u.A = A + (size_t)pm * tA; u.B = B + (size_t)pn * tB; u.row0 = pm * 256; u.pn = pn; u.aux = 256;
        } else {
            const int tile = (int)L >> 2, h = (int)L & 3; int row0, seq, nv;
            if (tile < 128) { row0 = tile * 256; seq = tile >> 4; nv = 256; } else { const int s = tile - 128; row0 = MP + s * 16; seq = 8 + s; nv = 16; }
            u.A = A + ((size_t)row0 * 1024 + h * 256) * 2;
            u.B = (mode == 1) ? B + ((size_t)seq * 256 * 1024 + h * 256) * 2 : B + ((size_t)h * 256 * VTLD + seq * 256) * 2;
            u.row0 = row0; u.pn = h; u.aux = nv;
        }
        return true;
    }
};


#define FOR_ROWS _Pragma("unroll") for (int ai = 0; ai < 2; ++ai) _Pragma("unroll") for (int m = 0; m < 4; ++m)
#define ROWDEF const int rt = ai * 128 + wr * 64 + m * 16 + fr; const size_t row = (size_t)u.row0 + rt; (void)rt;

__device__ __forceinline__ void epilogue(const int kind, CParams& p, const f32x4 (&acc)[2][2][4][2], const Unit& u, const int wr, const int wc, const int fr_in, const int fq_in) {
    int fr = fr_in, fq = fq_in; asm volatile("" : "+v"(fr), "+v"(fq));
    const int cw = wc * 32 + 8 * fq;
    switch (kind) {
    case E_G1: {
        if (u.pn < 4) {
            FOR_ROWS { ROWDEF
                const f32x4 a0 = acc[ai][0][m][0], a1 = acc[ai][0][m][1], b0 = sigm4(acc[ai][1][m][0]), b1 = sigm4(acc[ai][1][m][1]);
                *(u32x4*)(p.u + row * DCV + u.pn * 128 + cw) = pack8(a0 * b0, a1 * b1); }
        } else if (u.pn < 17) {
            FOR_ROWS { ROWDEF
#pragma unroll
                for (int bj = 0; bj < 2; ++bj) NTS(u32x4, p.pr + row * DSH + (u.pn - 4) * 256 + bj * 128 + cw, pack8(acc[ai][bj][m][0], acc[ai][bj][m][1])); }
        } else {
            FOR_ROWS { ROWDEF
#pragma unroll
                for (int bj = 0; bj < 2; ++bj) NTS(u32x4, p.gates + row * 2048 + (u.pn - 17) * 256 + bj * 128 + cw, pack8(sigm4(acc[ai][bj][m][0]), sigm4(acc[ai][bj][m][1]))); }
        }
    } break;
    case E_KV: {
        FOR_ROWS { ROWDEF
#pragma unroll
            for (int bj = 0; bj < 2; ++bj) {
                const int col = (u.pn & 3) * 256 + bj * 128 + cw;
                float* o = p.out + (u.pn < 4 ? O_MK : O_MV) + row * 1024 + col;
                NTS(f32x4, o, acc[ai][bj][m][0]); NTS(f32x4, o + 4, acc[ai][bj][m][1]);
                if (u.pn < 4) *(u32x4*)(p.Kb + row * 1024 + col) = pack8(acc[ai][bj][m][0], acc[ai][bj][m][1]);
            } }
    } break;
    case E_VT: {
        FOR_ROWS { ROWDEF
#pragma unroll
            for (int bj = 0; bj < 2; ++bj) *(u32x4*)(p.VT + row * VTLD + u.pn * 256 + bj * 128 + cw) = pack8(acc[ai][bj][m][0], acc[ai][bj][m][1]); }
    } break;
    case E_EA: {
        const float* bias = u.pn < 4 ? p.in[I_W0] : p.in[I_A0];
        bf16_t* o = u.pn < 4 ? p.ebuf : p.abuf;
        const float sc = u.pn < 4 ? 0.60653066f : 1.0f;
        f32x4 bv[2][2];
#pragma unroll
        for (int bj = 0; bj < 2; ++bj) { const int col = (u.pn & 3) * 256 + bj * 128 + cw; bv[bj][0] = *(const f32x4*)(bias + col); bv[bj][1] = *(const f32x4*)(bias + col + 4); }
        FOR_ROWS { ROWDEF
#pragma unroll
            for (int bj = 0; bj < 2; ++bj) {
                const int col = (u.pn & 3) * 256 + bj * 128 + cw;
                *(u32x4*)(o + row * 1024 + col) = pack8(sigm4(acc[ai][bj][m][0] + bv[bj][0]) * sc, sigm4(acc[ai][bj][m][1] + bv[bj][1]) * sc);
            } }
    } break;
    case E_G: {
#pragma unroll
        for (int ai = 0; ai < 2; ++ai) {
            u32x4 yv[4][2];
#pragma unroll
            for (int m = 0; m < 4; ++m) { ROWDEF
#pragma unroll
                for (int bj = 0; bj < 2; ++bj) yv[m][bj] = *(const u32x4*)(p.ybuf + row * 1024 + u.pn * 256 + bj * 128 + cw); }
#pragma unroll
            for (int m = 0; m < 4; ++m) { ROWDEF
#pragma unroll
                for (int bj = 0; bj < 2; ++bj) { f32x4 y0, y1; unpack8(yv[m][bj], y0, y1);
                    *(u32x4*)(p.ybuf + row * 1024 + u.pn * 256 + bj * 128 + cw) = pack8(y0 * acc[ai][bj][m][0], y1 * acc[ai][bj][m][1]); } }
        }
    } break;
    case E_CONV: {
#pragma unroll
        for (int ai = 0; ai < 2; ++ai) {
            u32x4 gv[4][2];
#pragma unroll
            for (int m = 0; m < 4; ++m) { ROWDEF
#pragma unroll
                for (int bj = 0; bj < 2; ++bj) gv[m][bj] = NTL(u32x4, p.gates + row * 2048 + u.pn * 256 + bj * 128 + cw); }
#pragma unroll
            for (int m = 0; m < 4; ++m) { ROWDEF
#pragma unroll
                for (int bj = 0; bj < 2; ++bj) { f32x4 g0, g1; unpack8(gv[m][bj], g0, g1);
                    *(u32x4*)(p.tmp + row * 1024 + u.pn * 256 + bj * 128 + cw) = pack8(g0 * acc[ai][bj][m][0], g1 * acc[ai][bj][m][1]); } }
        }
    } break;
    case E_RWKV: {
#pragma unroll
        for (int ai = 0; ai < 2; ++ai)
#pragma unroll
        for (int mh = 0; mh < 2; ++mh) {
            u32x4 gv[2][2], tv[2][2];
#pragma unroll
            for (int mm = 0; mm < 2; ++mm) { const int m = mh * 2 + mm; ROWDEF
#pragma unroll
                for (int bj = 0; bj < 2; ++bj) { const int col = u.pn * 256 + bj * 128 + cw; gv[mm][bj] = NTL(u32x4, p.gates + row * 2048 + 1024 + col); tv[mm][bj] = *(const u32x4*)(p.tmp + row * 1024 + col); } }
#pragma unroll
            for (int mm = 0; mm < 2; ++mm) { const int m = mh * 2 + mm; ROWDEF
#pragma unroll
                for (int bj = 0; bj < 2; ++bj) { f32x4 g0, g1, t0, t1; unpack8(gv[mm][bj], g0, g1); unpack8(tv[mm][bj], t0, t1);
                    *(u32x4*)(p.merged + row * 1024 + u.pn * 256 + bj * 128 + cw) = pack8(t0 + g0 * acc[ai][bj][m][0], t1 + g1 * acc[ai][bj][m][1]); } }
        }
    } break;
    case E_OUT: case E_OX: case E_DOWN: {
        float* ss = kind == E_OUT ? p.ss1 : (kind == E_OX ? p.ss2 : p.ss3);
#pragma unroll
        for (int ai = 0; ai < 2; ++ai)
#pragma unroll
        for (int mh = 0; mh < 2; ++mh) {
            f32x4 rv[2][2][2];
#pragma unroll
            for (int mm = 0; mm < 2; ++mm) { const int m = mh * 2 + mm; ROWDEF
                const float* rp = (kind == E_OUT) ? (row < (size_t)MP ? p.in[I_XP] + row * 1024 : p.in[I_XS] + (row - MP) * 1024) : p.out + row * 1024;
#pragma unroll
                for (int bj = 0; bj < 2; ++bj) { const int col = u.pn * 256 + bj * 128 + cw; rv[mm][bj][0] = NTL(f32x4, rp + col); rv[mm][bj][1] = NTL(f32x4, rp + col + 4); } }
#pragma unroll
            for (int mm = 0; mm < 2; ++mm) { const int m = mh * 2 + mm; ROWDEF
                float s = 0.f;
#pragma unroll
                for (int bj = 0; bj < 2; ++bj) {
                    const int col = u.pn * 256 + bj * 128 + cw;
                    const f32x4 h0 = rv[mm][bj][0] + acc[ai][bj][m][0], h1 = rv[mm][bj][1] + acc[ai][bj][m][1];
                    *(f32x4*)(p.out + row * 1024 + col) = h0; *(f32x4*)(p.out + row * 1024 + col + 4) = h1;
                    if (kind != E_DOWN) *(u32x4*)(p.hb + row * 1024 + col) = pack8(h0, h1);
                    s += dot4(h0, h0) + dot4(h1, h1);
                }
                if (kind != E_DOWN) { s += __shfl_xor(s, 16); s += __shfl_xor(s, 32); if (fq == 0) unsafeAtomicAdd(ss + row, s); }
            }
        }
    } break;
    case E_DOWN_HALF: {
        FOR_ROWS { ROWDEF
#pragma unroll
            for (int bj = 0; bj < 2; ++bj) { float* hp = p.out + row * 1024 + u.pn * 256 + bj * 128 + cw;
#pragma unroll
                for (int j = 0; j < 4; ++j) { unsafeAtomicAdd(hp + j, acc[ai][bj][m][0][j]); unsafeAtomicAdd(hp + 4 + j, acc[ai][bj][m][1][j]); } } }
    } break;
    case E_Q: {
        float rsv[2][4];
        FOR_ROWS { ROWDEF rsv[ai][m] = p.ss1[row]; }
        FOR_ROWS { ROWDEF
            const float rs = rsqrtf(rsv[ai][m] * (1.f / 1024.f) + 1e-6f);
#pragma unroll
            for (int bj = 0; bj < 2; ++bj) *(u32x4*)(p.q + row * 1024 + u.pn * 256 + bj * 128 + cw) = pack8(acc[ai][bj][m][0] * rs, acc[ai][bj][m][1] * rs);
        }
    } break;
    case E_S: {
        FOR_ROWS { ROWDEF
            float s = 0.f;
#pragma unroll
            for (int bj = 0; bj < 2; ++bj) {
                f32x4 e0, e1;
#pragma unroll
                for (int j = 0; j < 4; ++j) { e0[j] = __expf(acc[ai][bj][m][0][j] * 0.0625f); e1[j] = __expf(acc[ai][bj][m][1][j] * 0.0625f); }
                const u32x4 w = pack8(e0, e1);
                f32x4 r0, r1; unpack8(w, r0, r1);
                s += (r0[0] + r0[1]) + (r0[2] + r0[3]) + (r1[0] + r1[1]) + (r1[2] + r1[3]);
                if (rt < u.aux) *(u32x4*)(p.P + row * 1024 + u.pn * 256 + bj * 128 + cw) = w;
            }
            s += __shfl_xor(s, 16); s += __shfl_xor(s, 32);
            if (fq == 0 && rt < u.aux) unsafeAtomicAdd(p.psum + row * 4 + u.pn, s);
        }
    } break;
    case E_PV: {
        float pv[2][4];
        FOR_ROWS { ROWDEF pv[ai][m] = __hip_atomic_load(p.psum + (rt < u.aux ? row : (size_t)u.row0) * 4 + u.pn, __ATOMIC_RELAXED, __HIP_MEMORY_SCOPE_AGENT); }
        FOR_ROWS { ROWDEF
            if (rt < u.aux) {
                const float inv = 1.f / pv[ai][m];
#pragma unroll
                for (int bj = 0; bj < 2; ++bj) *(u32x4*)(p.ob + row * 1024 + u.pn * 256 + bj * 128 + cw) = pack8(acc[ai][bj][m][0] * inv, acc[ai][bj][m][1] * inv);
            }
        }
    } break;
    case E_FFN1: {
        float rsv[2][4];
        FOR_ROWS { ROWDEF rsv[ai][m] = p.ss2[row]; }
        FOR_ROWS { ROWDEF
            const float rs = rsqrtf(rsv[ai][m] * (1.f / 1024.f) + 1e-6f);
            const f32x4 g0 = acc[ai][0][m][0] * rs, g1 = acc[ai][0][m][1] * rs, u0 = acc[ai][1][m][0] * rs, u1 = acc[ai][1][m][1] * rs;
            *(u32x4*)(p.hid + row * DFF + u.pn * 128 + cw) = pack8(g0 * sigm4(g0) * u0, g1 * sigm4(g1) * u1);
        }
    } break;
    default: break;
    }
}

__device__ __forceinline__ void gemm_phase(LAS unsigned char* lds, CParams& p, const Job& jb) {
    const int tid = tid_opaque(), wid = __builtin_amdgcn_readfirstlane(tid >> 6), lane = tid & 63, wr = wid >> 2, wc = wid & 3, fr = lane & 15, fq = lane >> 4;
    Sched S; S.init(jb);
    const int K = jb.K, nt = K / BK, lda = jb.lda, ldb = jb.ldb;
    unsigned voffA[2], voffB[2];
#pragma unroll
    for (int i = 0; i < 2; ++i) { int R, C; stage_rc(tid * 16 + i * 8192, R, C); const int Rb = (R & ~31) + perm32(R & 31);
        voffA[i] = (unsigned)(R * lda + C) * 2u; voffB[i] = (unsigned)(Rb * ldb + C) * 2u; }
    const size_t kstep = (size_t)(BK * 2);
    const size_t hstepA = (size_t)HALF * lda * 2, hstepB = (size_t)HALF * ldb * 2;
    const unsigned ldsw = (unsigned)wid * 1024u;
    const int aoff = lds_byte(wr * 64 + fr, fq * 8), boff = lds_byte(wc * 32 + fr, fq * 8);
#define PG8_SA(b, h) (((b) * 2 + (h)) * HTB)
#define PG8_SB(b, h) ((4 + (b) * 2 + (h)) * HTB)
#define PG8_STAGE(bufoff, gbase, voff) do { _Pragma("unroll") for (int _i = 0; _i < 2; ++_i) \
        __builtin_amdgcn_global_load_lds((const unsigned*)((const char*)(gbase) + (voff)[_i]), (LAS unsigned*)(lds + (bufoff) + ldsw + _i * 8192), 16, 0, 0); } while (0)
#define PG8_LDA(dst, b, h) do { _Pragma("unroll") for (int m = 0; m < 4; ++m) _Pragma("unroll") for (int k = 0; k < 2; ++k) dst[m][k] = *(const LAS bf16x8*)(lds + PG8_SA(b, h) + aoff + m * 2048 + k * 1024); } while (0)
#define PG8_LDB(dst, b, h) do { _Pragma("unroll") for (int n = 0; n < 2; ++n) _Pragma("unroll") for (int k = 0; k < 2; ++k) dst[n][k] = *(const LAS bf16x8*)(lds + PG8_SB(b, h) + boff + n * 2048 + k * 1024); } while (0)
#define PG8_MMA(ai, bj, At, Bt) do { __builtin_amdgcn_s_setprio(1); _Pragma("unroll") for (int m = 0; m < 4; ++m) _Pragma("unroll") for (int n = 0; n < 2; ++n) _Pragma("unroll") for (int k = 0; k < 2; ++k) \
        acc[ai][bj][m][n] = __builtin_amdgcn_mfma_f32_16x16x32_bf16(Bt[n][k], At[m][k], acc[ai][bj][m][n], 0, 0, 0); __builtin_amdgcn_s_setprio(0); } while (0)
#define PG8_WAIT_V(n) asm volatile("s_waitcnt vmcnt(" #n ")" ::: "memory")
#define PG8_WAIT_L(n) asm volatile("s_waitcnt lgkmcnt(" #n ")" ::: "memory")
#define PG8_BAR __builtin_amdgcn_s_barrier()
#define PG8_SCHED __builtin_amdgcn_sched_barrier(0)
    Unit cur, nxt; int ui = 0;
    if (!S.next(0, cur)) return;
    f32x4 acc[2][2][4][2];
#pragma unroll
    for (int a = 0; a < 2; ++a)
#pragma unroll
        for (int b = 0; b < 2; ++b)
#pragma unroll
            for (int m = 0; m < 4; ++m)
#pragma unroll
                for (int n = 0; n < 2; ++n) acc[a][b][m][n] = (f32x4){0.f, 0.f, 0.f, 0.f};
    bf16x8 At[4][2], B0[2][2], B1[2][2];
    const char* cA = cur.A; const char* cB = cur.B;
    PG8_STAGE(PG8_SB(0, 0), cB, voffB); PG8_STAGE(PG8_SA(0, 0), cA, voffA); PG8_STAGE(PG8_SB(0, 1), cB + hstepB, voffB); PG8_STAGE(PG8_SA(0, 1), cA + hstepA, voffA);
    if (wr == 1) PG8_BAR;
    PG8_WAIT_V(4); PG8_BAR;
    PG8_STAGE(PG8_SB(1, 0), cB + kstep, voffB); PG8_STAGE(PG8_SA(1, 0), cA + kstep, voffA); PG8_STAGE(PG8_SB(1, 1), cB + hstepB + kstep, voffB);
    PG8_WAIT_V(6); PG8_BAR;
    for (;;) {
        const bool has_next = S.next(ui + 1, nxt);
        const char* nA = has_next ? nxt.A : cA; const char* nB = has_next ? nxt.B : cB;
        for (int t = 0; t < nt; t += 2) {
            const bool last = (t == nt - 2);
            const char* a1 = cA + (size_t)(t + 1) * kstep;
            const char* a2 = last ? nA : cA + (size_t)(t + 2) * kstep; const char* b2 = last ? nB : cB + (size_t)(t + 2) * kstep;
            const char* a3 = a2 + kstep; const char* b3 = b2 + kstep;
            PG8_LDB(B0, 0, 0); PG8_SCHED; PG8_LDA(At, 0, 0); PG8_STAGE(PG8_SA(1, 1), a1 + hstepA, voffA);
            PG8_WAIT_L(8); PG8_BAR; PG8_WAIT_L(0); PG8_MMA(0, 0, At, B0); PG8_BAR; PG8_SCHED;
            PG8_LDB(B1, 0, 1); PG8_STAGE(PG8_SB(0, 0), b2, voffB);
            PG8_BAR; PG8_WAIT_L(0); PG8_MMA(0, 1, At, B1); PG8_BAR;
            PG8_LDA(At, 0, 1); PG8_STAGE(PG8_SA(0, 0), a2, voffA);
            PG8_BAR; PG8_WAIT_L(0); PG8_MMA(1, 0, At, B0); PG8_BAR; PG8_SCHED;
            PG8_STAGE(PG8_SB(0, 1), b2 + hstepB, voffB);
            PG8_WAIT_V(6); PG8_BAR; PG8_MMA(1, 1, At, B1); PG8_BAR;
            PG8_LDB(B0, 1, 0); PG8_SCHED; PG8_LDA(At, 1, 0); PG8_STAGE(PG8_SA(0, 1), a2 + hstepA, voffA);
            PG8_WAIT_L(8); PG8_BAR; PG8_WAIT_L(0); PG8_MMA(0, 0, At, B0); PG8_BAR; PG8_SCHED;
            PG8_LDB(B1, 1, 1); PG8_STAGE(PG8_SB(1, 0), b3, voffB);
            PG8_BAR; PG8_WAIT_L(0); PG8_MMA(0, 1, At, B1); PG8_BAR;
            PG8_LDA(At, 1, 1); PG8_STAGE(PG8_SA(1, 0), a3, voffA);
            PG8_BAR; PG8_WAIT_L(0); PG8_MMA(1, 0, At, B0); PG8_BAR; PG8_SCHED;
            PG8_STAGE(PG8_SB(1, 1), b3 + hstepB, voffB);
            PG8_WAIT_V(6); PG8_BAR; PG8_MMA(1, 1, At, B1); PG8_BAR;
        }
        epilogue(cur.kind, p, acc, cur, wr, wc, fr, fq);
        if (!has_next) break;
#pragma unroll
        for (int a = 0; a < 2; ++a)
#pragma unroll
            for (int b = 0; b < 2; ++b)
#pragma unroll
                for (int m = 0; m < 4; ++m)
#pragma unroll
                    for (int n = 0; n < 2; ++n) acc[a][b][m][n] = (f32x4){0.f, 0.f, 0.f, 0.f};
        cur = nxt; cA = nA; cB = nB; ++ui;
    }
    PG8_WAIT_V(0);
    if (wr == 0) PG8_BAR;
    PG8_BAR;
}

__device__ __forceinline__ void convT(LAS float* tile, const float* src, const float* src2, int ldsrc, int K, int N, bf16_t* dst, int lddst, const float* scale, int mode) {
    const int tid = tid_opaque(), ntk = K / 64, ntn = N / 64, ntiles = ntk * ntn;
    float v[8];
    auto load_tile = [&](int t) {
        const int kt = t % ntk, nt_ = t / ntk, k0 = kt * 64, n0 = nt_ * 64;
        const float* s = src; int sc0 = n0;
        if (mode == 1 && n0 < 1024) { const int pn = n0 >> 8, w = n0 & 255, bj = w >> 7, c = w & 127; sc0 = bj * 512 + pn * 128 + c; }
        if (mode == 2) { const int pn = n0 >> 8, bj = (n0 >> 7) & 1, c = n0 & 127; sc0 = pn * 128 + c; s = bj ? src2 : src; }
#pragma unroll
        for (int i = 0; i < 8; ++i) { const int k = i * 8 + (tid >> 6), n = tid & 63;
            float x = __builtin_nontemporal_load(s + (size_t)(k0 + k) * ldsrc + sc0 + n); if (scale) x *= scale[k0 + k];
            v[i] = x; }
    };
    int t = blockIdx.x;
    if (t < ntiles) load_tile(t);
    for (; t < ntiles; t += gridDim.x) {
        const int kt = t % ntk, nt_ = t / ntk, k0 = kt * 64, n0 = nt_ * 64;
#pragma unroll
        for (int i = 0; i < 8; ++i) tile[(i * 8 + (tid >> 6)) * 65 + (tid & 63)] = v[i];
        __syncthreads();
        if (t + (int)gridDim.x < ntiles) load_tile(t + gridDim.x);
        { const int n = tid >> 3, kg = tid & 7; f32x4 a, b;
#pragma unroll
          for (int j = 0; j < 4; ++j) { a[j] = tile[(kg * 8 + j) * 65 + n]; b[j] = tile[(kg * 8 + 4 + j) * 65 + n]; }
          *(u32x4*)(dst + (size_t)(n0 + n) * lddst + k0 + kg * 8) = pack8(a, b); }
        __syncthreads();
    }
}

__device__ __forceinline__ void phase_prep(CParams& p, LAS unsigned char* lds) {
    const int tid = tid_opaque(), wid = tid >> 6, lane = tid & 63;
    const int gw = blockIdx.x * 8 + wid, nw = gridDim.x * 8;
    const size_t gt = (size_t)blockIdx.x * 512 + tid, ntot = (size_t)gridDim.x * 512;
    for (int row0 = gw; row0 < M + 2048; row0 += 2 * nw) {
        f32x4 v[2][4]; float ssq[2];
#pragma unroll
        for (int b = 0; b < 2; ++b) { const int rr = row0 + b * nw, row = rr < M + 2048 ? rr : row0;
            const float* src = row < MP ? p.in[I_XP] + (size_t)row * 1024 : (row < M ? p.in[I_XS] + (size_t)(row - MP) * 1024 : p.in[I_MEM] + (size_t)(row - M) * 1024);
#pragma unroll
            for (int i = 0; i < 4; ++i) v[b][i] = __builtin_nontemporal_load((const f32x4*)(src + lane * 4 + i * 256)); }
#pragma unroll
        for (int b = 0; b < 2; ++b) { float s = 0.f;
#pragma unroll
            for (int i = 0; i < 4; ++i) s += dot4(v[b][i], v[b][i]);
            ssq[b] = wave_sum(s); }
#pragma unroll
        for (int b = 0; b < 2; ++b) { const int row = row0 + b * nw;
            if (row < M + 2048) {
                bf16_t* dst = row < M ? p.xn + (size_t)row * 1024 : p.memn + (size_t)(row - M) * 1024;
                const float rs = rsqrtf(ssq[b] * (1.f / 1024.f) + 1e-6f);
#pragma unroll
                for (int i = 0; i < 4; ++i) { u32x2 w; w.x = pk2(v[b][i][0] * rs, v[b][i][1] * rs); w.y = pk2(v[b][i][2] * rs, v[b][i][3] * rs); *(u32x2*)(dst + lane * 4 + i * 256) = w; } } }
    }
    LAS float* tile = (LAS float*)lds;
    convT(tile, p.in[I_WIN], nullptr, 6400, 1024, 6400, p.WinT, 1024, p.in[I_GMIX], 1);
    convT(tile, p.in[I_WK], nullptr, 1024, 1024, 1024, p.WkvT, 1024, p.in[I_GMEM], 0);
    convT(tile, p.in[I_WV], nullptr, 1024, 1024, 1024, p.WkvT + (size_t)1024 * 1024, 1024, p.in[I_GMEM], 0);
    convT(tile, p.in[I_CV], nullptr, 1024, 16 * 256, 1024, p.VT + 8 * 256, VTLD, nullptr, 0);
    for (size_t i0 = gt; i0 < (size_t)16 * 256 * 1024 / 4; i0 += 4 * ntot) {
        f32x4 v[4];
#pragma unroll
        for (int b = 0; b < 4; ++b) { const size_t i = i0 + b * ntot; v[b] = NTL(f32x4, p.in[I_CK] + (i < (size_t)16 * 256 * 1024 / 4 ? i : i0) * 4); }
#pragma unroll
        for (int b = 0; b < 4; ++b) { const size_t i = i0 + b * ntot; if (i < (size_t)16 * 256 * 1024 / 4) { u32x2 w; w.x = pk2(v[b][0], v[b][1]); w.y = pk2(v[b][2], v[b][3]); *(u32x2*)(p.Kb + (size_t)8 * 256 * 1024 + i * 4) = w; } }
    }
    for (size_t i = gt; i < (size_t)3072 * 128; i += ntot) { const int n = (int)(i >> 7), k = (int)(i & 127); float v = 0.f; bf16_t* d;
        if (n < 1024) { if (k < 64) v = p.in[I_WUP][k * 1024 + n]; d = p.Wea + i; }
        else if (n < 2048) { if (k >= 64) v = p.in[I_AUP][(k - 64) * 1024 + (n - 1024)]; d = p.Wea + i; }
        else { v = p.in[I_GUP][k * 1024 + (n - 2048)]; d = p.Wg + (i - (size_t)2048 * 128); }
        *d = f2bf(v); }
    if (blockIdx.x == 0) for (int i = tid; i < XCD_BAR_WORDS; i += 512) p.bar[i] = 0u;
    for (size_t i = gt; i < (size_t)M; i += ntot) { p.ss1[i] = 0.f; p.ss2[i] = 0.f; p.ss3[i] = 0.f; }
    for (size_t i = gt; i < (size_t)M * 4; i += ntot) p.psum[i] = 0.f;
}

__device__ __forceinline__ void phase_conv(CParams& p, LAS unsigned char* lds) {
    const int tid = tid_opaque(), wid = tid >> 6, lane = tid & 63;
    const int gw = blockIdx.x * 8 + wid, nw = gridDim.x * 8;
    const size_t gt = (size_t)blockIdx.x * 512 + tid, ntot = (size_t)gridDim.x * 512;
    LAS float* wl = (LAS float*)lds;
    for (int i = tid; i < 31 * 512; i += 512) wl[i] = p.in[I_WDW][i];
    __syncthreads();
    const int ch0 = lane * 8;
    const f32x4 bd0 = *(const f32x4*)(p.in[I_BDW] + ch0), bd1 = *(const f32x4*)(p.in[I_BDW] + ch0 + 4);
    const f32x4 lg0 = *(const f32x4*)(p.in[I_LCG] + ch0), lg1 = *(const f32x4*)(p.in[I_LCG] + ch0 + 4);
    const f32x4 lb0 = *(const f32x4*)(p.in[I_LCB] + ch0), lb1 = *(const f32x4*)(p.in[I_LCB] + ch0 + 4);
    auto finish = [&](f32x4 c0, f32x4 c1, int mm) {
        const float mean = wave_sum((c0[0] + c0[1]) + (c0[2] + c0[3]) + (c1[0] + c1[1]) + (c1[2] + c1[3])) * (1.f / 512.f);
        c0 -= mean; c1 -= mean;
        const float var = wave_sum(dot4(c0, c0) + dot4(c1, c1)) * (1.f / 512.f);
        const float rstd = rsqrtf(var + 1e-5f);
        c0 = c0 * rstd * lg0 + lb0; c1 = c1 * rstd * lg1 + lb1;
        *(u32x4*)(p.sconv + (size_t)mm * DCV + ch0) = pack8(c0 * sigm4(c0), c1 * sigm4(c1));
    };
    auto boundary_token = [&](const int mm, const int tt, const int sidx, const bool prompt) {
        f32x4 c0 = bd0, c1 = bd1;
#pragma unroll 1
        for (int j0 = 0; j0 < 32; j0 += 8) {
            u32x4 xr[8]; f32x4 s0[8], s1[8];
#pragma unroll
            for (int jj = 0; jj < 8; ++jj) { const int j = j0 + jj; const bool ok = j < 31 && tt + j >= 30; xr[jj] = *(const u32x4*)(p.u + (size_t)(ok ? mm + j - 30 : mm) * DCV + ch0); }
            if (!prompt) {
#pragma unroll
                for (int jj = 0; jj < 8; ++jj) { const int j = j0 + jj, i = tt + j; const bool ok = j < 31 && i < 30;
                    const float* sp = p.in[I_SCONV] + ((size_t)sidx * 30 + (ok ? i : 0)) * 512 + ch0; s0[jj] = *(const f32x4*)sp; s1[jj] = *(const f32x4*)(sp + 4); }
            }
#pragma unroll
            for (int jj = 0; jj < 8; ++jj) { const int j = j0 + jj; const float f = (j < 31 && tt + j >= 30) ? 1.f : 0.f; const int jc = j < 31 ? j : 30; f32x4 x0, x1; unpack8(xr[jj], x0, x1);
                const f32x4 w0 = *(const LAS f32x4*)(wl + jc * 512 + ch0), w1 = *(const LAS f32x4*)(wl + jc * 512 + ch0 + 4);
                c0 += x0 * (w0 * f); c1 += x1 * (w1 * f);
                if (!prompt) { const float g = (j < 31 && tt + j < 30) ? 1.f : 0.f; c0 += s0[jj] * (w0 * g); c1 += s1[jj] * (w1 * g); } }
        }
        finish(c0, c1, mm);
    };
    for (int mp = gw; mp < MP / 2; mp += nw) {
        const int m = mp * 2, t = m & 4095;
        if (t >= 30) {
            u32x4 xr[32];
            const bf16_t* up = p.u + (size_t)(m - 30) * DCV + ch0;
#pragma unroll
            for (int j = 0; j < 32; ++j) xr[j] = *(const u32x4*)(up + (size_t)j * DCV);
            f32x4 a0 = bd0, a1 = bd1, b0 = bd0, b1 = bd1, x0, x1, y0, y1;
            unpack8(xr[0], x0, x1);
#pragma unroll
            for (int j = 0; j < 31; ++j) {
                unpack8(xr[j + 1], y0, y1);
                const f32x4 w0 = *(const LAS f32x4*)(wl + j * 512 + ch0), w1 = *(const LAS f32x4*)(wl + j * 512 + ch0 + 4);
                a0 += x0 * w0; a1 += x1 * w1; b0 += y0 * w0; b1 += y1 * w1;
                x0 = y0; x1 = y1;
            }
            finish(a0, a1, m); finish(b0, b1, m + 1);
        } else { boundary_token(m, t, 0, true); boundary_token(m + 1, t + 1, 0, true); }
    }
    for (int st = wid * (int)gridDim.x + (int)blockIdx.x; st < MS; st += nw) boundary_token(MP + st, st & 15, st >> 4, false);
    for (size_t i = gt; i < (size_t)8 * 30 * 512; i += ntot) { const int ch = (int)(i & 511), r = (int)((i >> 9) % 30), b = (int)(i / (30 * 512));
        p.out[O_CP + i] = bf2f(p.u[((size_t)b * 4096 + 4066 + r) * DCV + ch]); }
    for (size_t i = gt; i < (size_t)16 * 30 * 512; i += ntot) { const int ch = (int)(i & 511), r = (int)((i >> 9) % 30), s = (int)(i / (30 * 512));
        p.out[O_CS + i] = r < 14 ? p.in[I_SCONV][((size_t)s * 30 + 16 + r) * 512 + ch] : bf2f(p.u[((size_t)MP + s * 16 + (r - 14)) * DCV + ch]); }
    for (size_t i = gt; i < (size_t)24 * DSH; i += ntot) { const int sq = (int)(i / DSH), c = (int)(i % DSH);
        if (sq < 8) p.out[O_SP + i] = bf2f(p.pr[((size_t)sq * 4096 + 4095) * DSH + c]);
        else p.out[O_SS + (i - (size_t)8 * DSH)] = bf2f(p.pr[((size_t)MP + (sq - 8) * 16 + 15) * DSH + c]); }
    for (size_t it0 = gt; it0 < (size_t)M * 32; it0 += 2 * ntot) {
        u32x4 xc[2], xp[2]; f32x4 q0[2], q1[2], mu0[2], mu1[2]; bool val[2], first[2];
#pragma unroll
        for (int b = 0; b < 2; ++b) {
            const size_t it = it0 + b * ntot; val[b] = it < (size_t)M * 32; const size_t itc = val[b] ? it : it0;
            const int m = (int)(itc >> 5), c8 = (int)(itc & 31) * 8, col = 3072 + c8;
            const bool prompt = m < MP; const int t = prompt ? (m & 4095) : ((m - MP) & 15); const int s = prompt ? 0 : ((m - MP) >> 4);
            xc[b] = *(const u32x4*)(p.pr + (size_t)m * DSH + col);
            xp[b] = *(const u32x4*)(p.pr + (size_t)(t > 0 ? m - 1 : m) * DSH + col);
            first[b] = (t == 0);
            q0[b] = (f32x4){0.f, 0.f, 0.f, 0.f}; q1[b] = q0[b];
            if (t == 0 && !prompt) { const float* sp = p.in[I_SSHIFT] + (size_t)s * DSH + col; q0[b] = *(const f32x4*)sp; q1[b] = *(const f32x4*)(sp + 4); }
            mu0[b] = *(const f32x4*)(p.in[I_MU] + col); mu1[b] = *(const f32x4*)(p.in[I_MU] + col + 4);
        }
#pragma unroll
        for (int b = 0; b < 2; ++b) {
            const size_t it = it0 + b * ntot; const int m = (int)(it >> 5), c8 = (int)(it & 31) * 8;
            f32x4 x0, x1, w0, w1; unpack8(xc[b], x0, x1); unpack8(xp[b], w0, w1);
            if (first[b]) { w0 = q0[b]; w1 = q1[b]; }
            x0 = x0 + (w0 - x0) * mu0[b]; x1 = x1 + (w1 - x1) * mu1[b];
            if (c8 < 64) {
#pragma unroll
                for (int j = 0; j < 4; ++j) { x0[j] = tanhf(x0[j]); x1[j] = tanhf(x1[j]); }
            } else if (c8 >= 128) { x0 = sigm4(x0); x1 = sigm4(x1); }
            if (val[b]) *(u32x4*)(p.lin + (size_t)m * 256 + c8) = pack8(x0, x1);
        }
    }
}

struct LRaw { u32x4 r0, k0, v0, r1, k1, v1, a, e; };
struct ScanOps { f32x4 r0, r1, w0, w1, k0, k1, n0, n1, b0, b1; float v; };
__device__ __forceinline__ void scan_ld(ScanOps& o, const LAS float* sl, const LAS float* vp) {
    o.r0 = *(const LAS f32x4*)(sl); o.r1 = *(const LAS f32x4*)(sl + 32); o.w0 = *(const LAS f32x4*)(sl + 64); o.w1 = *(const LAS f32x4*)(sl + 96);
    o.k0 = *(const LAS f32x4*)(sl + 128); o.k1 = *(const LAS f32x4*)(sl + 160); o.n0 = *(const LAS f32x4*)(sl + 192); o.n1 = *(const LAS f32x4*)(sl + 224);
    o.b0 = *(const LAS f32x4*)(sl + 256); o.b1 = *(const LAS f32x4*)(sl + 288); o.v = *vp;
}
constexpr int SCH = 32, SBUF = SCH * 1536;
constexpr int YP_OFF = 2 * SBUF + 1536, YP_BYTES = 16 * 1024;
__device__ __forceinline__ void phase_scan(CParams& p, LAS unsigned char* lds) {
    const int tid = tid_opaque(), wid = __builtin_amdgcn_readfirstlane(tid >> 6), lane = tid & 63;
    const bool loader = wid >= 4;
    for (int item = blockIdx.x; item < 768; item += gridDim.x) {
        const bool prompt = item < 256; const int it = prompt ? item : item - 256; const int chain = it >> 1, hf = it & 1;
        const int b = chain >> 4, h = chain & 15;
        const int T = prompt ? 4096 : 16; const size_t m0 = prompt ? (size_t)b * 4096 : (size_t)MP + b * 16;
        const int nch = (T + SCH - 1) / SCH;
        if (loader) {
            const int lw = wid - 4, sl = lane >> 3, g = lane & 7, ch0 = h * 64 + 8 * g;
            const float* mu = p.in[I_MU];
            const f32x4 mur0 = *(const f32x4*)(mu + ch0), mur1 = *(const f32x4*)(mu + ch0 + 4), muk0 = *(const f32x4*)(mu + 1024 + ch0), muk1 = *(const f32x4*)(mu + 1024 + ch0 + 4),
                        muv0 = *(const f32x4*)(mu + 2048 + ch0), muv1 = *(const f32x4*)(mu + 2048 + ch0 + 4);
            const f32x4 kkc0 = *(const f32x4*)(p.in[I_KK] + ch0), kkc1 = *(const f32x4*)(p.in[I_KK] + ch0 + 4), kac0 = *(const f32x4*)(p.in[I_KA] + ch0), kac1 = *(const f32x4*)(p.in[I_KA] + ch0 + 4),
                        rkc0 = *(const f32x4*)(p.in[I_RK] + ch0), rkc1 = *(const f32x4*)(p.in[I_RK] + ch0 + 4);
            LRaw cur, nxt;
            auto load_chunk = [&](int c, LRaw& L) {
                const int t = c * SCH + lw * 8 + sl; const size_t m = m0 + t, mp = t > 0 ? m - 1 : m;
                const bf16_t* pc = p.pr + m * DSH + ch0; const bf16_t* pp = p.pr + mp * DSH + ch0;
                L.r0 = *(const u32x4*)pc; L.k0 = *(const u32x4*)(pc + 1024); L.v0 = *(const u32x4*)(pc + 2048);
                L.r1 = *(const u32x4*)pp; L.k1 = *(const u32x4*)(pp + 1024); L.v1 = *(const u32x4*)(pp + 2048);
                L.a = *(const u32x4*)(p.abuf + m * 1024 + ch0); L.e = *(const u32x4*)(p.ebuf + m * 1024 + ch0);
            };
            auto process = [&](int c, const LRaw& L) {
                const int sidx = lw * 8 + sl, t = c * SCH + sidx; const size_t m = m0 + t;
                f32x4 r0, r1, k0, k1, v0, v1, pr0, pr1, pk0, pk1, pv0, pv1, a0, a1, e0, e1;
                unpack8(L.r0, r0, r1); unpack8(L.k0, k0, k1); unpack8(L.v0, v0, v1); unpack8(L.r1, pr0, pr1); unpack8(L.k1, pk0, pk1); unpack8(L.v1, pv0, pv1);
                unpack8(L.a, a0, a1); unpack8(L.e, e0, e1);
                if (c == 0 && lw == 0) {
                    f32x4 q[6];
#pragma unroll
                    for (int i = 0; i < 6; ++i) q[i] = (f32x4){0.f, 0.f, 0.f, 0.f};
                    if (!prompt) { const float* sp = p.in[I_SSHIFT] + (size_t)b * DSH + ch0;
                        q[0] = *(const f32x4*)sp; q[1] = *(const f32x4*)(sp + 4); q[2] = *(const f32x4*)(sp + 1024); q[3] = *(const f32x4*)(sp + 1028); q[4] = *(const f32x4*)(sp + 2048); q[5] = *(const f32x4*)(sp + 2052); }
                    if (sl == 0) { pr0 = q[0]; pr1 = q[1]; pk0 = q[2]; pk1 = q[3]; pv0 = q[4]; pv1 = q[5]; }
                }
                r0 = r0 + (pr0 - r0) * mur0; r1 = r1 + (pr1 - r1) * mur1; k0 = k0 + (pk0 - k0) * muk0; k1 = k1 + (pk1 - k1) * muk1; v0 = v0 + (pv0 - v0) * muv0; v1 = v1 + (pv1 - v1) * muv1;
                f32x4 w0, w1;
#pragma unroll
                for (int i = 0; i < 4; ++i) { w0[i] = __expf(-e0[i]); w1[i] = __expf(-e1[i]); }
                f32x4 kk0 = k0 * kkc0, kk1 = k1 * kkc1;
                const float n2 = reduce8(dot4(kk0, kk0) + dot4(kk1, kk1)), inv = 1.f / fmaxf(sqrtf(n2), 1e-12f);
                kk0 = kk0 * inv; kk1 = kk1 * inv;
                const f32x4 k20 = k0 * (1.f + (a0 - 1.f) * kac0), k21 = k1 * (1.f + (a1 - 1.f) * kac1), bb0 = kk0 * a0, bb1 = kk1 * a1;
                const float rks = reduce8(dot4(r0 * k20, rkc0) + dot4(r1 * k21, rkc1));
                if (g == 0 && hf == 0 && t < T) p.rk[m * 16 + h] = rks;
                LAS float* so = (LAS float*)(lds + (c & 1) * SBUF + sidx * 1536) + 8 * g;
                *(LAS f32x4*)(so) = r0; *(LAS f32x4*)(so + 4) = r1; *(LAS f32x4*)(so + 64) = w0; *(LAS f32x4*)(so + 68) = w1;
                *(LAS f32x4*)(so + 128) = k20; *(LAS f32x4*)(so + 132) = k21; *(LAS f32x4*)(so + 192) = -kk0; *(LAS f32x4*)(so + 196) = -kk1;
                *(LAS f32x4*)(so + 256) = bb0; *(LAS f32x4*)(so + 260) = bb1; *(LAS f32x4*)(so + 320) = v0; *(LAS f32x4*)(so + 324) = v1;
            };
            const int L = lw * 64 + lane;
            auto reduce_y = [&](int buf, int t0) {
                const LAS float* yb = (const LAS float*)(lds + YP_OFF + buf * YP_BYTES);
#pragma unroll
                for (int i = 0; i < 2; ++i) { const int idx = i * 256 + L, step = idx >> 5, r = idx & 31;
                    const f32x4 a = *(const LAS f32x4*)(yb + idx * 8), bq = *(const LAS f32x4*)(yb + idx * 8 + 4);
                    const float y = ((a[0] + a[1]) + (a[2] + a[3])) + ((bq[0] + bq[1]) + (bq[2] + bq[3]));
                    p.ybuf[(m0 + t0 + step) * 1024 + h * 64 + hf * 32 + r] = f2bf(y); }
            };
            load_chunk(0, cur);
            if (nch > 1) load_chunk(1, nxt);
            process(0, cur);
            __syncthreads();
            for (int c = 0; c < nch; ++c) {
                const int nst = (T - c * SCH) < SCH ? (T - c * SCH) : SCH;
                if (c + 1 < nch) {
                    cur = nxt;
                    if (c + 2 < nch) load_chunk(c + 2, nxt);
                    process(c + 1, cur);
                }
                if (c > 0) reduce_y(1, (c - 1) * SCH + 16);
                __syncthreads();
                if (nst > 16) { reduce_y(0, c * SCH); __syncthreads(); }
            }
            { const int lastn = T - (nch - 1) * SCH; if (lastn > 16) reduce_y(1, (nch - 1) * SCH + 16); else reduce_y(0, (nch - 1) * SCH); }
            __syncthreads();
        } else {
            const int j = lane & 7, row = hf * 32 + wid * 8 + (lane >> 3);
            f32x2 S[4];
#pragma unroll
            for (int i = 0; i < 4; ++i) S[i] = (f32x2){0.f, 0.f};
            if (!prompt) { const float* sp = p.in[I_SWKV] + ((size_t)chain * 64 + row) * 64; const f32x4 a = *(const f32x4*)(sp + 4 * j), bq = *(const f32x4*)(sp + 32 + 4 * j);
                S[0] = a.lo; S[1] = a.hi; S[2] = bq.lo; S[3] = bq.hi; }
            __syncthreads();
            for (int c = 0; c < nch; ++c) {
                const LAS float* base = (const LAS float*)(lds + (c & 1) * SBUF) + 4 * j;
                const LAS float* vb = (const LAS float*)(lds + (c & 1) * SBUF) + 320 + row;
                const int nst = (T - c * SCH) < SCH ? (T - c * SCH) : SCH;
                ScanOps cur, nxt;
                scan_ld(cur, base, vb);
                for (int g16 = 0; g16 < nst; g16 += 16) {
                    unsigned ywb = (unsigned)(YP_OFF + (g16 >> 4) * YP_BYTES + (wid * 64 + lane) * 4);
                    asm volatile("" : "+v"(ywb));
                    LAS float* yw = (LAS float*)(lds + ywb);
#pragma unroll
                    for (int s16 = 0; s16 < 16; ++s16) {
                        scan_ld(nxt, base + (g16 + s16 + 1) * 384, vb + (g16 + s16 + 1) * 384);
                        f32x2 d = S[0] * cur.n0.lo; d = S[1] * cur.n0.hi + d; d = S[2] * cur.n1.lo + d; d = S[3] * cur.n1.hi + d;
                        const float sa = reduce8(d.x + d.y);
                        const f32x2 sa2 = (f32x2){sa, sa}, v2 = (f32x2){cur.v, cur.v};
                        S[0] = S[0] * cur.w0.lo + (cur.b0.lo * sa2 + cur.k0.lo * v2);
                        S[1] = S[1] * cur.w0.hi + (cur.b0.hi * sa2 + cur.k0.hi * v2);
                        S[2] = S[2] * cur.w1.lo + (cur.b1.lo * sa2 + cur.k1.lo * v2);
                        S[3] = S[3] * cur.w1.hi + (cur.b1.hi * sa2 + cur.k1.hi * v2);
                        f32x2 e = S[0] * cur.r0.lo; e = S[1] * cur.r0.hi + e; e = S[2] * cur.r1.lo + e; e = S[3] * cur.r1.hi + e;
                        yw[s16 * 256] = e.x + e.y;
                        cur = nxt;
                    }
                    __syncthreads();
                }
            }
            float* so = p.out + (prompt ? O_WP : O_WS) + ((size_t)chain * 64 + row) * 64;
            *(f32x4*)(so + 4 * j) = (f32x4){S[0].x, S[0].y, S[1].x, S[1].y}; *(f32x4*)(so + 32 + 4 * j) = (f32x4){S[2].x, S[2].y, S[3].x, S[3].y};
            __syncthreads();
        }
    }
}

__device__ __forceinline__ void phase_yn(CParams& p, LAS unsigned char* lds) {
    const int tid = tid_opaque(), wid = tid >> 6, lane = tid & 63;
    const int gw = blockIdx.x * 8 + wid, nw = gridDim.x * 8;
    {
        const int half = gw & 1, c0 = half * 512 + lane * 8, h = c0 >> 6;
        const f32x4 mu0 = *(const f32x4*)(p.in[I_MU] + 2048 + c0), mu1 = *(const f32x4*)(p.in[I_MU] + 2048 + c0 + 4);
        const f32x4 lg0 = *(const f32x4*)(p.in[I_LXG] + c0), lg1 = *(const f32x4*)(p.in[I_LXG] + c0 + 4);
        const f32x4 lb0 = *(const f32x4*)(p.in[I_LXB] + c0), lb1 = *(const f32x4*)(p.in[I_LXB] + c0 + 4);
        for (int it0 = gw; it0 < M * 2; it0 += 2 * nw) {
            u32x4 yr[2], vc[2], vp[2]; f32x4 q0[2], q1[2]; float rkv[2]; bool val[2], usef[2];
#pragma unroll
            for (int b = 0; b < 2; ++b) {
                const int it = it0 + b * nw; val[b] = it < M * 2; const int m = val[b] ? (it >> 1) : 0;
                const bool prompt = m < MP; const int t = prompt ? (m & 4095) : ((m - MP) & 15); const int sq = prompt ? 0 : ((m - MP) >> 4);
                yr[b] = *(const u32x4*)(p.ybuf + (size_t)m * 1024 + c0);
                vc[b] = NTL(u32x4, p.pr + (size_t)m * DSH + 2048 + c0);
                vp[b] = NTL(u32x4, p.pr + (size_t)(t > 0 ? m - 1 : m) * DSH + 2048 + c0);
                usef[b] = (t == 0);
                q0[b] = (f32x4){0.f, 0.f, 0.f, 0.f}; q1[b] = q0[b];
                if (t == 0 && !prompt) { const float* sp = p.in[I_SSHIFT] + (size_t)sq * DSH + 2048 + c0; q0[b] = *(const f32x4*)sp; q1[b] = *(const f32x4*)(sp + 4); }
                rkv[b] = p.rk[(size_t)m * 16 + h];
            }
#pragma unroll
            for (int b = 0; b < 2; ++b) {
                const int it = it0 + b * nw; const int m = it >> 1;
                f32x4 y0, y1, v0, v1, w0, w1; unpack8(yr[b], y0, y1); unpack8(vc[b], v0, v1); unpack8(vp[b], w0, w1);
                if (usef[b]) { w0 = q0[b]; w1 = q1[b]; }
                const float mean = reduce8((y0[0] + y0[1]) + (y0[2] + y0[3]) + (y1[0] + y1[1]) + (y1[2] + y1[3])) * (1.f / 64.f);
                y0 -= mean; y1 -= mean;
                const float rstd = rsqrtf(reduce8(dot4(y0, y0) + dot4(y1, y1)) * (1.f / 64.f) + 64e-5f);
                v0 = v0 + (w0 - v0) * mu0; v1 = v1 + (w1 - v1) * mu1;
                y0 = y0 * rstd * lg0 + lb0 + v0 * rkv[b]; y1 = y1 * rstd * lg1 + lb1 + v1 * rkv[b];
                if (val[b]) *(u32x4*)(p.ybuf + (size_t)m * 1024 + c0) = pack8(y0, y1);
            }
        }
    }
    LAS float* tile = (LAS float*)lds;
    convT(tile, p.in[I_WOC], nullptr, 1024, 512, 1024, p.WocT, 512, nullptr, 0);
    convT(tile, p.in[I_WOR], nullptr, 1024, 1024, 1024, p.WorT, 1024, nullptr, 0);
    convT(tile, p.in[I_WOUT], nullptr, 1024, 1024, 1024, p.WoutT, 1024, nullptr, 0);
    convT(tile, p.in[I_WQ], nullptr, 1024, 1024, 1024, p.WqT, 1024, p.in[I_GX], 0);
    convT(tile, p.in[I_WOX], nullptr, 1024, 1024, 1024, p.WoxT, 1024, nullptr, 0);
    convT(tile, p.in[I_WFG], p.in[I_WFU], 2816, 1024, 5632, p.WguT, 1024, p.in[I_GFFN], 2);
    convT(tile, p.in[I_WFD], nullptr, 1024, 2816, 1024, p.WdT, 2816, nullptr, 0);
}

__device__ __forceinline__ void phase_final(CParams& p) {
    const int tid = tid_opaque(), wid = tid >> 6, lane = tid & 63;
    const int gw = blockIdx.x * 8 + wid, nw = gridDim.x * 8;
    f32x4 gfin[4];
#pragma unroll
    for (int i = 0; i < 4; ++i) gfin[i] = *(const f32x4*)(p.in[I_GFIN] + lane * 4 + i * 256);
    for (int row0 = gw; row0 < M; row0 += 2 * nw) {
        f32x4 v[2][4]; float sv[2];
#pragma unroll
        for (int b = 0; b < 2; ++b) { const int rr = row0 + b * nw, row = rr < M ? rr : row0;
#pragma unroll
            for (int i = 0; i < 4; ++i) v[b][i] = __builtin_nontemporal_load((const f32x4*)(p.out + (size_t)row * 1024 + lane * 4 + i * 256)); }
#pragma unroll
        for (int b = 0; b < 2; ++b) { float q = 0.f;
#pragma unroll
            for (int i = 0; i < 4; ++i) q += dot4(v[b][i], v[b][i]);
            sv[b] = wave_sum(q); }
#pragma unroll
        for (int b = 0; b < 2; ++b) { const int row = row0 + b * nw;
            if (row < M) { const float rs = rsqrtf(sv[b] * (1.f / 1024.f) + 1e-6f);
#pragma unroll
                for (int i = 0; i < 4; ++i) __builtin_nontemporal_store(v[b][i] * rs * gfin[i], (f32x4*)(p.out + (size_t)row * 1024 + lane * 4 + i * 256)); } }
    }
}


enum { NK_EA = 0, NK_G, NK_CONV, NK_RWKV, NK_OUT, NK_Q, NK_OX, NK_FFN1, NK_DOWN };
__device__ __forceinline__ u32x2 pack4(f32x4 v) { u32x2 w; w.x = pk2(v[0], v[1]); w.y = pk2(v[2], v[3]); return w; }
__device__ __forceinline__ f32x4 unpack4w(u32x2 w) { return (f32x4){bf_lo(w.x), bf_hi(w.x), bf_lo(w.y), bf_hi(w.y)}; }
__device__ __forceinline__ void narrow_job(CParams& p, LAS unsigned char* lds, const int nk, const bf16_t* A, const int lda, const int K, const bf16_t* B, const int ldb, const int nstrips) {
    const int tid = tid_opaque(), wid = __builtin_amdgcn_readfirstlane(tid >> 6), lane = tid & 63, fr = lane & 15, fq = lane >> 4, kh = wid >> 2, wq = wid & 3;
    LAS f32x4* red = (LAS f32x4*)lds;
    const int KH = K / 2, nks = KH / 32;
    for (int uidx = blockIdx.x; uidx < nstrips * 4; uidx += gridDim.x) {
        const int strip = uidx >> 2, rq = uidx & 3, c0 = strip * 16;
        const bf16_t* b0p; const bf16_t* b1p;
        if (nk == NK_FFN1) { const int pn = c0 >> 7, w = c0 & 127; b0p = B + (size_t)(pn * 256 + w + fr) * ldb + 8 * fq + kh * KH; b1p = b0p + (size_t)128 * ldb; }
        else { b0p = B + (size_t)(c0 + fr) * ldb + 8 * fq + kh * KH; b1p = b0p; }
        const size_t row = (size_t)MP + rq * 64 + wq * 16 + fr;
        const bf16_t* ap = A + row * lda + 8 * fq + kh * KH;
        f32x4 acc0 = (f32x4){0.f, 0.f, 0.f, 0.f}, acc1 = acc0;
        for (int kb = 0; kb < nks; kb += 8) {
            {
                bf16x8 av[8], bv[8], cv[8];
#pragma unroll
                for (int i = 0; i < 8; ++i) if (kb + i < nks) { av[i] = *(const bf16x8*)(ap + (kb + i) * 32); bv[i] = *(const bf16x8*)(b0p + (kb + i) * 32); if (nk == NK_FFN1) cv[i] = *(const bf16x8*)(b1p + (kb + i) * 32); }
#pragma unroll
                for (int i = 0; i < 8; ++i) if (kb + i < nks) { acc0 = __builtin_amdgcn_mfma_f32_16x16x32_bf16(bv[i], av[i], acc0, 0, 0, 0);
                    if (nk == NK_FFN1) acc1 = __builtin_amdgcn_mfma_f32_16x16x32_bf16(cv[i], av[i], acc1, 0, 0, 0); }
            }
        }
        if (kh == 1) { red[(wq * 64 + lane) * 2] = acc0; if (nk == NK_FFN1) red[(wq * 64 + lane) * 2 + 1] = acc1; }
        __syncthreads();
        if (kh == 0) {
            const f32x4 v = acc0 + red[(wq * 64 + lane) * 2]; const int c = c0 + 4 * fq;
            switch (nk) {
            case NK_EA: {
                if (c < 1024) { const f32x4 bias = *(const f32x4*)(p.in[I_W0] + c); *(u32x2*)(p.ebuf + row * 1024 + c) = pack4(sigm4(v + bias) * 0.60653066f); }
                else { const f32x4 bias = *(const f32x4*)(p.in[I_A0] + (c - 1024)); *(u32x2*)(p.abuf + row * 1024 + (c - 1024)) = pack4(sigm4(v + bias)); }
            } break;
            case NK_G: { bf16_t* yp = p.ybuf + row * 1024 + c; const f32x4 y = unpack4w(*(const u32x2*)yp); *(u32x2*)yp = pack4(y * v); } break;
            case NK_CONV: { const f32x4 g1 = unpack4w(*(const u32x2*)(p.gates + row * 2048 + c)); *(u32x2*)(p.tmp + row * 1024 + c) = pack4(g1 * v); } break;
            case NK_RWKV: { const f32x4 g2 = unpack4w(*(const u32x2*)(p.gates + row * 2048 + 1024 + c)), tq = unpack4w(*(const u32x2*)(p.tmp + row * 1024 + c));
                *(u32x2*)(p.merged + row * 1024 + c) = pack4(tq + g2 * v); } break;
            case NK_OUT: case NK_OX: {
                const float* rp = (nk == NK_OUT) ? p.in[I_XS] + (row - MP) * 1024 + c : p.out + row * 1024 + c;
                const f32x4 h = *(const f32x4*)rp + v;
                *(f32x4*)(p.out + row * 1024 + c) = h; *(u32x2*)(p.hb + row * 1024 + c) = pack4(h);
                float sq = dot4(h, h); sq += __shfl_xor(sq, 16); sq += __shfl_xor(sq, 32);
                if (fq == 0) unsafeAtomicAdd((nk == NK_OUT ? p.ss1 : p.ss2) + row, sq);
            } break;
            case NK_DOWN: { float* hp = p.out + row * 1024 + c; *(f32x4*)hp = *(const f32x4*)hp + v; } break;
            case NK_Q: { const float rs = rsqrtf(p.ss1[row] * (1.f / 1024.f) + 1e-6f); *(u32x2*)(p.q + row * 1024 + c) = pack4(v * rs); } break;
            case NK_FFN1: { const float rs = rsqrtf(p.ss2[row] * (1.f / 1024.f) + 1e-6f); const f32x4 g = v * rs, uu = (acc1 + red[(wq * 64 + lane) * 2 + 1]) * rs;
                *(u32x2*)(p.hid + row * DFF + c) = pack4(g * sigm4(g) * uu); } break;
            default: break;
            }
        }
        __syncthreads();
    }
}

__device__ __forceinline__ void narrow_attn(CParams& p) {
    const int tid = tid_opaque(), wid = __builtin_amdgcn_readfirstlane(tid >> 6), lane = tid & 63, fr = lane & 15, fq = lane >> 4;
    for (int pair = blockIdx.x; pair < 64; pair += gridDim.x) {
        const int sq = pair >> 2, h = pair & 3; const size_t row = (size_t)MP + sq * 16 + fr;
        {
            const bf16_t* ap = p.q + row * 1024 + h * 256 + 8 * fq;
            bf16x8 av[8], bv[2][8];
#pragma unroll
            for (int k = 0; k < 8; ++k) av[k] = *(const bf16x8*)(ap + k * 32);
#pragma unroll
            for (int u = 0; u < 2; ++u) { const bf16_t* bp = p.Kb + ((size_t)(8 + sq) * 256 + (wid * 2 + u) * 16 + fr) * 1024 + h * 256 + 8 * fq;
#pragma unroll
                for (int k = 0; k < 8; ++k) bv[u][k] = *(const bf16x8*)(bp + k * 32); }
#pragma unroll
            for (int u = 0; u < 2; ++u) {
                f32x4 acc = (f32x4){0.f, 0.f, 0.f, 0.f};
#pragma unroll
                for (int k = 0; k < 8; ++k) acc = __builtin_amdgcn_mfma_f32_16x16x32_bf16(bv[u][k], av[k], acc, 0, 0, 0);
                f32x4 e;
#pragma unroll
                for (int j = 0; j < 4; ++j) e[j] = __expf(acc[j] * 0.0625f);
                const u32x2 w = pack4(e); const f32x4 r = unpack4w(w);
                *(u32x2*)(p.P + row * 1024 + h * 256 + (wid * 2 + u) * 16 + 4 * fq) = w;
                float sm = (r[0] + r[1]) + (r[2] + r[3]); sm += __shfl_xor(sm, 16); sm += __shfl_xor(sm, 32);
                if (fq == 0) unsafeAtomicAdd(p.psum + row * 4 + h, sm);
            }
        }
        asm volatile("s_waitcnt vmcnt(0)" ::: "memory");
        __syncthreads();
        {
            const bf16_t* ap = p.P + row * 1024 + h * 256 + 8 * fq;
            bf16x8 av[8], bv[2][8];
#pragma unroll
            for (int k = 0; k < 8; ++k) av[k] = *(const bf16x8*)(ap + k * 32);
#pragma unroll
            for (int u = 0; u < 2; ++u) { const bf16_t* bp = p.VT + ((size_t)h * 256 + (wid * 2 + u) * 16 + fr) * VTLD + (size_t)(8 + sq) * 256 + 8 * fq;
#pragma unroll
                for (int k = 0; k < 8; ++k) bv[u][k] = *(const bf16x8*)(bp + k * 32); }
            const float inv = 1.f / __hip_atomic_load(p.psum + row * 4 + h, __ATOMIC_RELAXED, __HIP_MEMORY_SCOPE_AGENT);
#pragma unroll
            for (int u = 0; u < 2; ++u) {
                f32x4 acc = (f32x4){0.f, 0.f, 0.f, 0.f};
#pragma unroll
                for (int k = 0; k < 8; ++k) acc = __builtin_amdgcn_mfma_f32_16x16x32_bf16(bv[u][k], av[k], acc, 0, 0, 0);
                *(u32x2*)(p.ob + row * 1024 + h * 256 + (wid * 2 + u) * 16 + 4 * fq) = pack4(acc * inv);
            }
        }
    }
}

__device__ __forceinline__ void narrow_phase(CParams& p, LAS unsigned char* lds, const int ph) {
    switch (ph) {
    case 3: narrow_job(p, lds, NK_EA, p.lin, 256, 128, p.Wea, 128, 128); break;
    case 6: narrow_job(p, lds, NK_G, p.lin + 128, 256, 128, p.Wg, 128, 64); break;
    case 7: narrow_job(p, lds, NK_CONV, p.sconv, 512, 512, p.WocT, 512, 64); narrow_job(p, lds, NK_RWKV, p.ybuf, 1024, 1024, p.WorT, 1024, 64); break;
    case 8: narrow_job(p, lds, NK_OUT, p.merged, 1024, 1024, p.WoutT, 1024, 64); break;
    case 9: narrow_job(p, lds, NK_Q, p.hb, 1024, 1024, p.WqT, 1024, 64); break;
    case 12: narrow_job(p, lds, NK_OX, p.ob, 1024, 1024, p.WoxT, 1024, 64); break;
    case 13: narrow_job(p, lds, NK_FFN1, p.hb, 1024, 1024, p.WguT, 1024, 176); break;
    case 14: narrow_job(p, lds, NK_DOWN, p.hid, DFF, DFF, p.WdT, DFF, 64); break;
    default: break;
    }
}

__device__ __forceinline__ bool get_job(CParams& p, int ph, int j, Job& jb) {
    jb.mode = 0; jb.lda = 1024; jb.ldb = 1024; jb.K = 1024; jb.Mrows = M; jb.N = 1024; jb.A2 = nullptr; jb.B2 = nullptr;
    const void* A = nullptr; const void* B = nullptr; bool ok = (j == 0);
    switch (ph) {
    case 1: A = p.xn; B = p.WinT; jb.N = 6400; jb.kind = E_G1; jb.mode = 3; jb.A2 = (const char*)p.memn; jb.B2 = (const char*)p.WkvT; break;
    case 3: A = p.lin; B = p.Wea; jb.lda = 256; jb.ldb = 128; jb.K = 128; jb.N = 2048; jb.kind = E_EA; jb.Mrows = MP; break;
    case 6: A = p.lin + 128; B = p.Wg; jb.lda = 256; jb.ldb = 128; jb.K = 128; jb.kind = E_G; jb.Mrows = MP; break;
    case 7:
        ok = j < 2; jb.Mrows = MP;
        if (j == 0) { A = p.sconv; B = p.WocT; jb.lda = 512; jb.ldb = 512; jb.K = 512; jb.kind = E_CONV; }
        else { A = p.ybuf; B = p.WorT; jb.kind = E_RWKV; }
        break;
    case 8: A = p.merged; B = p.WoutT; jb.kind = E_OUT; jb.Mrows = MP; break;
    case 9: A = p.hb; B = p.WqT; jb.kind = E_Q; jb.Mrows = MP; break;
    case 10:
        ok = j < 2;
        if (j == 0) { A = p.q; B = p.Kb; jb.K = 256; jb.mode = 1; jb.kind = E_S; }
        else { A = p.P; B = p.VT; jb.K = 256; jb.ldb = VTLD; jb.mode = 2; jb.kind = E_PV; }
        break;
    case 12: A = p.ob; B = p.WoxT; jb.kind = E_OX; jb.Mrows = MP; break;
    case 13: A = p.hb; B = p.WguT; jb.N = 5632; jb.kind = E_FFN1; jb.Mrows = MP; break;
    case 14:
        A = p.hid; B = p.WdT; jb.lda = DFF; jb.ldb = DFF; jb.K = DFF; jb.Mrows = MP; jb.kind = E_DOWN; break;
    default: ok = false; break;
    }
    jb.A = (const char*)A; jb.B = (const char*)B;
    return ok;
}

__global__ void __launch_bounds__(512, 2) mega(Params p_unused) {
    CParams& p = *(CParams*)__builtin_amdgcn_kernarg_segment_ptr();
    extern __shared__ __attribute__((aligned(16))) unsigned char shm[];
    LAS unsigned char* lds = (LAS unsigned char*)shm;
    cg::grid_group grid = cg::this_grid();
    volatile LAS unsigned* st = (volatile LAS unsigned*)(lds + LDS_ST);
    if (threadIdx.x < 2) st[threadIdx.x] = 0u;
    XcdBarrier xb; xb.bar = p.bar; xb.x = 0; xb.st = st;
    for (int ph = p.ph_lo; ph < p.ph_hi; ++ph) {
#ifdef PROBE_PH
        for (int rep = 0; rep < (ph == PROBE_PH ? 2 : 1); ++rep) {
#endif
        switch (ph) {
        case 0: phase_prep(p, lds); break;
        case 2: phase_conv(p, lds); break;
        case 4: phase_scan(p, lds); break;
        case 5: phase_yn(p, lds); break;
        case 15: phase_final(p); break;
        default: break;
        }
        for (int j = 0; j < 3; ++j) { Job jb; if (!get_job(p, ph, j, jb)) break; gemm_phase(lds, p, jb); }
        narrow_phase(p, lds, ph);
        if (ph == 10) narrow_attn(p);
#ifdef PROBE_PH
        }
#endif
        if (ph + 1 < p.ph_hi) {
            if (ph == 0) {
                grid.sync();
                xb = xcd_barrier_post(p.bar, st);
            } else if (ph != 10) xcd_barrier(xb);
        }
    }
}

extern "C" void kernel_launch(void* const* d_in, const int* in_sizes, int n_in, void* d_out, int out_size, void* d_ws, size_t ws_size, hipStream_t stream) {
    static int grid_blocks = 0;
    if (!grid_blocks) {
        int dev = 0, cus = 0, per_cu = 0;
        hipGetDevice(&dev);
        hipDeviceGetAttribute(&cus, hipDeviceAttributeMultiprocessorCount, dev);
        hipFuncSetAttribute((const void*)mega, hipFuncAttributeMaxDynamicSharedMemorySize, LDS_BYTES);
        hipOccupancyMaxActiveBlocksPerMultiprocessor(&per_cu, (const void*)mega, 512, LDS_BYTES);
        if (per_cu < 1) { fprintf(stderr, "occupancy query returned %d\n", per_cu); per_cu = 1; }
        grid_blocks = cus * per_cu;
    }
    Params p{};
    for (int i = 0; i < N_IN; ++i) p.in[i] = (const float*)d_in[i];
    p.out = (float*)d_out;
    unsigned char* w = (unsigned char*)d_ws; size_t off = 0;
    auto take = [&](size_t bytes) { unsigned char* r = w + off; off += (bytes + 255) & ~(size_t)255; return r; };
    p.WinT = (bf16_t*)take((size_t)6400 * 1024 * 2); p.WkvT = (bf16_t*)take((size_t)2048 * 1024 * 2);
    p.Wea = (bf16_t*)take((size_t)2048 * 256 * 2); p.Wg = (bf16_t*)take((size_t)1024 * 256 * 2);
    p.Kb = (bf16_t*)take((size_t)24 * 256 * 1024 * 2); p.VT = (bf16_t*)take((size_t)1024 * VTLD * 2);
    p.ss1 = (float*)take((size_t)M * 4); p.ss2 = (float*)take((size_t)M * 4); p.ss3 = (float*)take((size_t)M * 4);
    p.psum = (float*)take((size_t)M * 16); p.rk = (float*)take((size_t)M * 64);
    p.bar = (unsigned*)take((size_t)XCD_BAR_WORDS * 4);
    unsigned char* RA = take((size_t)MPAD * 1024 * 2); p.xn = (bf16_t*)RA; p.ebuf = (bf16_t*)RA; p.hb = (bf16_t*)RA;
    unsigned char* RB = take((size_t)M * DSH * 2); p.pr = (bf16_t*)RB; p.hid = (bf16_t*)RB;
    p.tmp = (bf16_t*)RB; p.q = (bf16_t*)RB; p.merged = (bf16_t*)(RB + (size_t)MPAD * 1024 * 2); p.ob = p.merged; p.P = (bf16_t*)(RB + (size_t)2 * MPAD * 1024 * 2);
    p.lin = (bf16_t*)take((size_t)M * 256 * 2);
    unsigned char* RD = take((size_t)MPAD * 1024 * 2); p.u = (bf16_t*)RD; p.ybuf = (bf16_t*)RD;
    unsigned char* RE = take((size_t)M * 1024 * 2); p.memn = (bf16_t*)RE; p.abuf = (bf16_t*)RE;
    { size_t o = 0; auto sub = [&](size_t bytes) { unsigned char* r = RE + o; o += (bytes + 255) & ~(size_t)255; return (bf16_t*)r; };
      p.WocT = sub((size_t)1024 * 512 * 2); p.WorT = sub((size_t)1024 * 1024 * 2); p.WoutT = sub((size_t)1024 * 1024 * 2); p.WqT = sub((size_t)1024 * 1024 * 2);
      p.WoxT = sub((size_t)1024 * 1024 * 2); p.WguT = sub((size_t)5632 * 1024 * 2); p.WdT = sub((size_t)1024 * DFF * 2); }
    p.sconv = (bf16_t*)take((size_t)M * 512 * 2);
    p.gates = (bf16_t*)d_out;
    if (off > ws_size) { fprintf(stderr, "workspace too small: need %zu have %zu\n", off, ws_size); return; }
    p.ph_lo = 0; p.ph_hi = NPHASE;
    void* args[] = {&p};
    hipError_t e = hipLaunchCooperativeKernel((const void*)mega, dim3(grid_blocks), dim3(512), args, LDS_BYTES, stream);
    if (e != hipSuccess) fprintf(stderr, "cooperative launch failed: %s (grid %d)\n", hipGetErrorString(e), grid_blocks);
}
```
